# Optimizing an MI355X kernel written in HIP

```python
import jax, jax.numpy as jnp
from jax import lax
import numpy as np

D_MODEL = 1024
BATCH = 8
SEQ = 8192
DEPTH = 4

POOL_WINDOWS = (2, 4, 8, 16)
N_POOL_GROUPS = 4
POOL_GROUP_DIM = D_MODEL // 16
POOL_WIDTH = N_POOL_GROUPS * POOL_GROUP_DIM
HEAD_DIM = 64
N_Q_HEADS = D_MODEL // 128
N_KV_HEADS = 2
GROUP = N_Q_HEADS // N_KV_HEADS
Q_WIDTH = N_Q_HEADS * HEAD_DIM
KV_WIDTH = N_KV_HEADS * HEAD_DIM
WINDOW = 128
ROT_DIM = HEAD_DIM // 4
ROPE_THETA = 500000.0
CONV_WIDTH = D_MODEL // 4
CONV_K = 3
N_BRANCHES = 3
IN_WIDTH = POOL_WIDTH + Q_WIDTH + 2 * KV_WIDTH + 3 * CONV_WIDTH + N_BRANCHES * D_MODEL
D_FF = ((8 * D_MODEL // 3 + 127) // 128) * 128
FFN_K = 3
ALPHA = (2 * DEPTH) ** 0.25
BETA = (8 * DEPTH) ** -0.25
LN_EPS = 1e-5
MASK_VALUE = -1e30

kernel_name = "hybrid_pool_swa_shortconv_deepnorm"


def _split_points(sizes):
    pts, acc = [], 0
    for s in sizes[:-1]:
        acc += s
        pts.append(acc)
    return pts


def layer_norm(x, g, b):
    xf = x.astype(jnp.float32)
    mu = jnp.mean(xf, axis=-1, keepdims=True)
    var = jnp.mean(jnp.square(xf - mu), axis=-1, keepdims=True)
    y = (xf - mu) * lax.rsqrt(var + LN_EPS)
    return (y * g.astype(jnp.float32) + b.astype(jnp.float32)).astype(x.dtype)


def causal_dwconv(u, w):
    K = w.shape[0]
    S = u.shape[1]
    up = jnp.pad(u, ((0, 0), (K - 1, 0), (0, 0)))
    y = up[:, 0:S] * w[0]
    for k in range(1, K):
        y = y + up[:, k:k + S] * w[k]
    return y


def rope_tables(positions):
    inv_freq = ROPE_THETA ** (-jnp.arange(0, ROT_DIM, 2, dtype=jnp.float32) / ROT_DIM)
    ang = positions.astype(jnp.float32)[..., None] * inv_freq
    return jnp.cos(ang), jnp.sin(ang)


def apply_partial_rope(t, cos, sin):
    tf = t.astype(jnp.float32)
    half = ROT_DIM // 2
    x1, x2, rest = tf[..., :half], tf[..., half:ROT_DIM], tf[..., ROT_DIM:]
    c, s = cos[:, :, None, :], sin[:, :, None, :]
    out = jnp.concatenate([x1 * c - x2 * s, x2 * c + x1 * s, rest], axis=-1)
    return out.astype(t.dtype)


def multiscale_pool_mixer(u, w_pool, pool_scale):
    B, S, _ = u.shape
    ug = u.reshape(B, S, N_POOL_GROUPS, POOL_GROUP_DIM).astype(jnp.float32)
    csum = jnp.cumsum(ug, axis=1)
    t = jnp.arange(S)
    outs = []
    for g, w in enumerate(POOL_WINDOWS):
        c = csum[:, :, g]
        c_lag = jnp.pad(c[:, :S - w], ((0, 0), (w, 0), (0, 0)))
        count = jnp.minimum(t + 1, w).astype(jnp.float32)[None, :, None]
        outs.append((c - c_lag) / count - ug[:, :, g])
    pooled = jnp.stack(outs, axis=2).astype(u.dtype)
    mixed = jnp.einsum('bsgc,gcd->bsgd', pooled, w_pool)
    return mixed.reshape(B, S, POOL_WIDTH) * pool_scale


def sliding_window_gqa_sinks(q, k, v, sinks):
    B, S, _, D = q.shape
    nb = S // WINDOW
    qb = q.reshape(B, nb, WINDOW, N_KV_HEADS, GROUP, D)
    kb = k.reshape(B, nb, WINDOW, N_KV_HEADS, D)
    vb = v.reshape(B, nb, WINDOW, N_KV_HEADS, D)
    pad = ((0, 0), (1, 0), (0, 0), (0, 0), (0, 0))
    kcat = jnp.concatenate([jnp.pad(kb[:, :-1], pad), kb], axis=2)
    vcat = jnp.concatenate([jnp.pad(vb[:, :-1], pad), vb], axis=2)
    scores = jnp.einsum('bnqhgd,bnkhd->bnhgqk', qb, kcat).astype(jnp.float32)
    scores = scores * (HEAD_DIM ** -0.5)
    i = jnp.arange(WINDOW)[:, None]
    j = jnp.arange(2 * WINDOW)[None, :]
    band = (j > i) & (j <= i + WINDOW)
    blk = jnp.arange(nb)[:, None, None]
    valid = band[None] & ((blk > 0) | (j[None] >= WINDOW))
    scores = jnp.where(valid[None, :, None, None], scores, MASK_VALUE)
    sink = jnp.broadcast_to(
        sinks.astype(jnp.float32).reshape(1, 1, N_KV_HEADS, GROUP, 1, 1),
        scores.shape[:-1] + (1,))
    probs = jax.nn.softmax(jnp.concatenate([scores, sink], axis=-1), axis=-1)[..., :-1]
    out = jnp.einsum('bnhgqk,bnkhd->bnqhgd', probs.astype(v.dtype), vcat)
    return out.reshape(B, S, N_Q_HEADS * D)


def short_gated_conv(xc, gate_b, gate_c, conv_w):
    return gate_b * causal_dwconv(gate_c * xc, conv_w)


def hybrid_layer(x, cos, sin, w_in, w_pool, pool_scale, attn_sinks, conv_w,
                 w_branch_a, w_branch_b, w_branch_c, w_o, ln1_g, ln1_b,
                 w_up, ffn_conv_w, w_down, ln2_g, ln2_b):
    B, S, _ = x.shape
    proj = jnp.einsum('bsd,de->bse', x, w_in)
    sizes = [POOL_WIDTH, Q_WIDTH, KV_WIDTH, KV_WIDTH,
             CONV_WIDTH, CONV_WIDTH, CONV_WIDTH, N_BRANCHES * D_MODEL]
    u_pool, q, k, v, xc, gate_b, gate_c, gate_logits = jnp.split(
        proj, _split_points(sizes), axis=-1)
    o_a = multiscale_pool_mixer(u_pool, w_pool, pool_scale)
    q = apply_partial_rope(q.reshape(B, S, N_Q_HEADS, HEAD_DIM), cos, sin)
    k = apply_partial_rope(k.reshape(B, S, N_KV_HEADS, HEAD_DIM), cos, sin)
    v = v.reshape(B, S, N_KV_HEADS, HEAD_DIM)
    o_b = sliding_window_gqa_sinks(q, k, v, attn_sinks)
    o_c = short_gated_conv(xc, gate_b, gate_c, conv_w)
    gates = jax.nn.sigmoid(gate_logits).reshape(B, S, N_BRANCHES, D_MODEL)
    merged = (gates[:, :, 0] * jnp.einsum('bsc,cd->bsd', o_a, w_branch_a)
              + gates[:, :, 1] * jnp.einsum('bsc,cd->bsd', o_b, w_branch_b)
              + gates[:, :, 2] * jnp.einsum('bsc,cd->bsd', o_c, w_branch_c))
    mix = jnp.einsum('bsd,de->bse', merged, w_o)
    x = layer_norm(ALPHA * x + mix, ln1_g, ln1_b)
    up = causal_dwconv(jnp.einsum('bsd,df->bsf', x, w_up), ffn_conv_w)
    a, b = jnp.split(up, 2, axis=-1)
    ffn = jnp.einsum('bsf,fd->bsd', jax.nn.silu(a) * b, w_down)
    return layer_norm(ALPHA * x + ffn, ln2_g, ln2_b)


def setup_inputs(seed: int = 0) -> dict:
    key = jax.random.key(seed)
    ks = jax.random.split(key, 20)
    nrm = lambda k, shape, scale: jax.random.normal(k, shape, jnp.float32) * scale
    x = nrm(ks[0], (BATCH, SEQ, D_MODEL), 1.0)
    offset = jax.random.randint(ks[1], (BATCH, 1), 0, 1024, dtype=jnp.int32)
    positions = offset + jnp.arange(SEQ, dtype=jnp.int32)[None, :]
    return {
        "x": x,
        "positions": positions,
        "w_in": nrm(ks[2], (DEPTH, D_MODEL, IN_WIDTH), D_MODEL ** -0.5),
        "w_pool": nrm(ks[3], (DEPTH, N_POOL_GROUPS, POOL_GROUP_DIM, POOL_GROUP_DIM), POOL_GROUP_DIM ** -0.5),
        "pool_scale": 1.0 + nrm(ks[4], (DEPTH, POOL_WIDTH), 0.1),
        "attn_sinks": nrm(ks[5], (DEPTH, N_Q_HEADS), 0.5),
        "conv_w": nrm(ks[6], (DEPTH, CONV_K, CONV_WIDTH), CONV_K ** -0.5),
        "w_branch_a": nrm(ks[7], (DEPTH, POOL_WIDTH, D_MODEL), POOL_WIDTH ** -0.5),
        "w_branch_b": nrm(ks[8], (DEPTH, Q_WIDTH, D_MODEL), Q_WIDTH ** -0.5),
        "w_branch_c": nrm(ks[9], (DEPTH, CONV_WIDTH, D_MODEL), CONV_WIDTH ** -0.5),
        "w_o": nrm(ks[10], (DEPTH, D_MODEL, D_MODEL), BETA * D_MODEL ** -0.5),
        "ln1_g": 1.0 + nrm(ks[11], (DEPTH, D_MODEL), 0.02),
        "ln1_b": nrm(ks[12], (DEPTH, D_MODEL), 0.02),
        "w_up": nrm(ks[13], (DEPTH, D_MODEL, 2 * D_FF), D_MODEL ** -0.5),
        "ffn_conv_w": nrm(ks[14], (DEPTH, FFN_K, 2 * D_FF), FFN_K ** -0.5),
        "w_down": nrm(ks[15], (DEPTH, D_FF, D_MODEL), BETA * D_FF ** -0.5),
        "ln2_g": 1.0 + nrm(ks[16], (DEPTH, D_MODEL), 0.02),
        "ln2_b": nrm(ks[17], (DEPTH, D_MODEL), 0.02),
    }


def reference(x, positions, w_in, w_pool, pool_scale, attn_sinks, conv_w,
              w_branch_a, w_branch_b, w_branch_c, w_o, ln1_g, ln1_b,
              w_up, ffn_conv_w, w_down, ln2_g, ln2_b):
    cos, sin = rope_tables(positions)
    for l in range(DEPTH):
        x = hybrid_layer(x, cos, sin, w_in[l], w_pool[l], pool_scale[l], attn_sinks[l],
                         conv_w[l], w_branch_a[l], w_branch_b[l], w_branch_c[l], w_o[l],
                         ln1_g[l], ln1_b[l], w_up[l], ffn_conv_w[l], w_down[l],
                         ln2_g[l], ln2_b[l])
    return x
```

```cpp
#include <hip/hip_runtime.h>
#include <hip/hip_cooperative_groups.h>
#include <cstdio>
#include <cmath>
namespace cg = cooperative_groups;
namespace pg8 {
#define PG8_LAS __attribute__((address_space(3)))
typedef unsigned short bf16_t;
typedef short bf16x8 __attribute__((ext_vector_type(8)));
typedef float f32x4 __attribute__((ext_vector_type(4)));
typedef unsigned u32x4 __attribute__((ext_vector_type(4)));
constexpr int BM = 256, BK = 64, HALF = 128, HTB = HALF * BK * 2  , STAGE_BYTES = 8 * HTB, NXCD = 8, WGM = 8;

__host__ __device__ __forceinline__ int lds_byte(int r, int c) { const int st = (r >> 4) * 2 + (c >> 5), rr = r & 15, cc = c & 31, ob = rr * 64 + cc * 2; return st * 1024 + (ob ^ (((ob >> 9) & 1) << 5)); }
__host__ __device__ __forceinline__ void stage_rc(int b, int& R, int& C) { const int st = b / 1024, sb = b % 1024, swz = sb ^ (((sb >> 9) & 1) << 5); R = (st >> 1) * 16 + swz / 64; C = (st & 1) * 32 + (swz % 64) / 2; }
__host__ __device__ __forceinline__ int perm32(int rho) { const int n = rho >> 4, i = rho & 15; return 8 * (i >> 2) + 4 * n + (i & 3); }

struct Unit { int pm, pn; };
struct Gemm { const bf16_t* A; const bf16_t* Bt; int M, N, K; };

struct StaticOrder {
    int nM, nN, nwg, G, c;
    __host__ __device__ void init(int M, int N, int G_, int c_) { nM = M / BM; nN = N / BM; nwg = nM * nN; G = G_; c = c_; }
    __host__ __device__ bool next(int i, Unit& u) const {
        const long L = (long)i * G + c; if (L >= nwg) return false;
        int wgid = (int)L; { const int q = nwg / NXCD, r = nwg % NXCD, xcd = wgid % NXCD, off = wgid / NXCD; wgid = (xcd < r ? xcd * (q + 1) : r * (q + 1) + (xcd - r) * q) + off; }
        const int nig = WGM * nN, gid = wgid / nig, fm = gid * WGM, gsz = (nM - fm) < WGM ? (nM - fm) : WGM;
        u.pm = fm + ((wgid % nig) % gsz); u.pn = (wgid % nig) / gsz; return true;
    }
    __device__ __forceinline__ void a_ready(const Unit&) const {}
    __device__ __forceinline__ void done(const Unit&) const {}
};
struct CountedOrder : StaticOrder {
    const unsigned* ready; unsigned need; unsigned* tmo;
    __device__ __forceinline__ void a_ready(const Unit& u) const {
        if (threadIdx.x < 64) {
            const unsigned long long t0 = __builtin_amdgcn_s_memrealtime(); unsigned polls = 0;
            while ((unsigned)__builtin_amdgcn_readfirstlane(__hip_atomic_load(ready + 64 * u.pm, __ATOMIC_RELAXED, __HIP_MEMORY_SCOPE_AGENT)) < need) {
                if ((++polls & 255u) == 0u && __builtin_amdgcn_readfirstlane(__hip_atomic_load(tmo, __ATOMIC_RELAXED, __HIP_MEMORY_SCOPE_AGENT)) != 0u) break;
                if (__builtin_amdgcn_s_memrealtime() - t0 > 2000000ull) {
                    if (threadIdx.x == 0) { unsigned expect = 0u; __hip_atomic_compare_exchange_strong(tmo + 1, &expect, 0x600u | (unsigned)(u.pm & 0xff), __ATOMIC_RELAXED, __ATOMIC_RELAXED, __HIP_MEMORY_SCOPE_AGENT); __hip_atomic_store(tmo, 1u, __ATOMIC_RELAXED, __HIP_MEMORY_SCOPE_AGENT); }
                    break; }
                __builtin_amdgcn_s_sleep(2); }
            __builtin_amdgcn_fence(__ATOMIC_ACQUIRE, "agent");
            asm volatile("s_waitcnt vmcnt(0)" ::: "memory");
        }
#if !defined(BROKEN_HOOK_NO_BARRIER)
        asm volatile("" ::: "memory"); __builtin_amdgcn_s_barrier(); asm volatile("" ::: "memory");
#endif
    }
};

__device__ __forceinline__ unsigned cvt_pk_bf16(float lo, float hi) { unsigned r; asm volatile("v_cvt_pk_bf16_f32 %0, %1, %2" : "=v"(r) : "v"(lo), "v"(hi)); return r; }
typedef float f32x2 __attribute__((ext_vector_type(2)));
__device__ __forceinline__ f32x2 gelu_pk(f32x2 v) {
    const f32x2 av = __builtin_elementwise_abs(v), d = av * 0.2316418882f + 1.0f;
    f32x2 t; t.x = __builtin_amdgcn_rcpf(d.x); t.y = __builtin_amdgcn_rcpf(d.y);
    f32x2 q = t * 0.5307027145f + (-0.7265760135f); q = q * t + 0.7107068705f; q = q * t + (-0.142248368f); q = q * t + 0.127414796f; q = q * t;
    const f32x2 s = (v * v) * (-0.72134752044f);
    f32x2 e; e.x = __builtin_amdgcn_exp2f(s.x); e.y = __builtin_amdgcn_exp2f(s.y);
    const f32x2 m = v * (q * e), r = v - m;
    f32x2 o; o.x = v.x < 0.f ? m.x : r.x; o.y = v.y < 0.f ? m.y : r.y; return o;
}

struct EpiF32 {
    static constexpr bool PERM = false, AFTER_DRAIN = false, MID = false;
    float* C; int ldc; const float* bias;
    __device__ __forceinline__ void operator()(const f32x4 (&acc)[2][2][4][2], const Unit& u, int wr, int wc, int fr, int fq) const {
        const int row0 = u.pm * BM + wr * 64 + fr, col0 = u.pn * BM + wc * 32 + 4 * fq;
        f32x4 bv[2][2];
#pragma unroll
        for (int bj = 0; bj < 2; ++bj)
#pragma unroll
            for (int n = 0; n < 2; ++n) bv[bj][n] = bias ? *(const f32x4*)(bias + col0 + bj * HALF + n * 16) : (f32x4){0.f, 0.f, 0.f, 0.f};
#pragma unroll
        for (int ai = 0; ai < 2; ++ai)
#pragma unroll
            for (int m = 0; m < 4; ++m) { float* rowp = C + (size_t)(row0 + ai * HALF + m * 16) * ldc + col0;
#pragma unroll
                for (int bj = 0; bj < 2; ++bj)
#pragma unroll
                    for (int n = 0; n < 2; ++n) *(f32x4*)(rowp + bj * HALF + n * 16) = acc[ai][bj][m][n] + bv[bj][n]; }
    }
};
template <int ACT  > struct EpiBf16 {
    static constexpr bool PERM = true, AFTER_DRAIN = false, MID = false;
    bf16_t* O; int ldc; const float* bias; int split_cols; size_t split_stride;
    __device__ __forceinline__ void operator()(const f32x4 (&acc)[2][2][4][2], const Unit& u, int wr, int wc, int fr, int fq) const {
        const int row0 = u.pm * BM + wr * 64 + fr; int colt = u.pn * BM; bf16_t* base = O;
        if (split_cols) { const int t = colt / split_cols; base += (size_t)t * split_stride; colt -= t * split_cols; }
        const int col0 = colt + wc * 32 + 8 * fq, bcol0 = u.pn * BM + wc * 32 + 8 * fq;
        f32x4 bv[2][2];
#pragma unroll
        for (int bj = 0; bj < 2; ++bj)
#pragma unroll
            for (int n = 0; n < 2; ++n) bv[bj][n] = bias ? *(const f32x4*)(bias + bcol0 + bj * HALF + 4 * n) : (f32x4){0.f, 0.f, 0.f, 0.f};
#pragma unroll
        for (int ai = 0; ai < 2; ++ai)
#pragma unroll
            for (int m = 0; m < 4; ++m) { bf16_t* rowp = base + (size_t)(row0 + ai * HALF + m * 16) * ldc + col0;
#pragma unroll
                for (int bj = 0; bj < 2; ++bj) { f32x4 v0 = acc[ai][bj][m][0] + bv[bj][0], v1 = acc[ai][bj][m][1] + bv[bj][1];
                    if (ACT == 1) { f32x2 a = gelu_pk((f32x2){v0[0], v0[1]}), b = gelu_pk((f32x2){v0[2], v0[3]}), c = gelu_pk((f32x2){v1[0], v1[1]}), d = gelu_pk((f32x2){v1[2], v1[3]});
                        v0 = (f32x4){a.x, a.y, b.x, b.y}; v1 = (f32x4){c.x, c.y, d.x, d.y}; }
                    if (ACT == 2) {
#pragma unroll
                        for (int j = 0; j < 4; ++j) { v0[j] = 0.5f * v0[j] * (1.0f + erff(v0[j] * 0.70710678f)); v1[j] = 0.5f * v1[j] * (1.0f + erff(v1[j] * 0.70710678f)); } }
                    u32x4 w; w.x = cvt_pk_bf16(v0[0], v0[1]); w.y = cvt_pk_bf16(v0[2], v0[3]); w.z = cvt_pk_bf16(v1[0], v1[1]); w.w = cvt_pk_bf16(v1[2], v1[3]);
                    *(u32x4*)(rowp + bj * HALF) = w; } }
    }
};

struct PanelStats {
    unsigned* xbuf;
    unsigned* cnt;
    unsigned* tmo;
    int ntn; float eps;
    unsigned code;
    __device__ __forceinline__ bool run(const f32x4 (&v)[2][2][4][2], const Unit& u, int wr, int wc, int fr, int fq, PG8_LAS unsigned char* lds, int wid, int lane) const {
        typedef float f32x2v __attribute__((ext_vector_type(2)));
        PG8_LAS f32x2v* P = (PG8_LAS f32x2v*)lds;
        PG8_LAS f32x2v* S = (PG8_LAS f32x2v*)(lds + 8192);
        PG8_LAS unsigned* flag = (PG8_LAS unsigned*)(lds + 8192 + 2048);
#pragma unroll
        for (int ai = 0; ai < 2; ++ai)
#pragma unroll
            for (int m = 0; m < 4; ++m) {
                float s = 0.f;
#pragma unroll
                for (int bj = 0; bj < 2; ++bj)
#pragma unroll
                    for (int n = 0; n < 2; ++n) { const f32x4 x = v[ai][bj][m][n]; s += (x[0] + x[1]) + (x[2] + x[3]); }
                s += __shfl_xor(s, 16); s += __shfl_xor(s, 32);
                const float mw = s * (1.0f / 64.0f); float q = 0.f;
#pragma unroll
                for (int bj = 0; bj < 2; ++bj)
#pragma unroll
                    for (int n = 0; n < 2; ++n) { const f32x4 d = v[ai][bj][m][n] - mw; q += (d[0] * d[0] + d[1] * d[1]) + (d[2] * d[2] + d[3] * d[3]); }
                q += __shfl_xor(q, 16); q += __shfl_xor(q, 32);
                if (fq == 0) P[(ai * HALF + wr * 64 + m * 16 + fr) * 4 + wc] = (f32x2v){mw, q};
            }
        asm volatile("s_waitcnt lgkmcnt(0)" ::: "memory"); __builtin_amdgcn_s_barrier(); asm volatile("" ::: "memory");
#if defined(BROKEN_NO_WAIT)
        if (blockIdx.x >= 64) { const long long t0 = clock64(); while (clock64() - t0 < 60000) __builtin_amdgcn_s_sleep(8); }
#endif
        const int row = wid * 32 + (lane & 31);
        if (lane < 32) {
            const f32x2v a = P[row * 4 + 0], b = P[row * 4 + 1], c = P[row * 4 + 2], d = P[row * 4 + 3];
            const float mt = (a.x + b.x + c.x + d.x) * 0.25f;
            const float da = a.x - mt, db = b.x - mt, dc = c.x - mt, dd = d.x - mt;
            const float m2 = (a.y + b.y) + (c.y + d.y) + 64.0f * ((da * da + db * db) + (dc * dc + dd * dd));
            unsigned long long* slot = (unsigned long long*)xbuf + ((size_t)(u.pm * BM + row) * 4 + u.pn);
            __hip_atomic_store(slot, ((unsigned long long)__float_as_uint(m2) << 32) | __float_as_uint(mt), __ATOMIC_RELAXED, __HIP_MEMORY_SCOPE_AGENT);
        }
        asm volatile("s_waitcnt vmcnt(0)" ::: "memory");
        if (lane == 0) __hip_atomic_fetch_add(cnt + 64 * u.pm, 1u, __ATOMIC_RELAXED, __HIP_MEMORY_SCOPE_AGENT);
        if (wid == 0) {
            bool dead = false; const unsigned long long t0 = __builtin_amdgcn_s_memrealtime(); const unsigned want = 8u * (unsigned)ntn;
            for (;;) {
#if defined(BROKEN_NO_WAIT)
                break;
#endif
                if ((unsigned)__builtin_amdgcn_readfirstlane(__hip_atomic_load(cnt + 64 * u.pm, __ATOMIC_RELAXED, __HIP_MEMORY_SCOPE_AGENT)) >= want) break;
                if (__builtin_amdgcn_s_memrealtime() - t0 > 2000000ull) {
                    if (lane == 0) { unsigned expect = 0u; __hip_atomic_compare_exchange_strong(tmo + 1, &expect, code | (unsigned)(u.pm & 0xff), __ATOMIC_RELAXED, __ATOMIC_RELAXED, __HIP_MEMORY_SCOPE_AGENT);
                                     __hip_atomic_store(tmo, 1u, __ATOMIC_RELAXED, __HIP_MEMORY_SCOPE_AGENT); }
                    dead = true; break; }
                __builtin_amdgcn_s_sleep(2);
            }
            __builtin_amdgcn_fence(__ATOMIC_ACQUIRE, "agent");
            if (lane == 0) flag[0] = dead ? 1u : 0u;
        }
        asm volatile("s_waitcnt vmcnt(0) lgkmcnt(0)" ::: "memory"); __builtin_amdgcn_s_barrier(); asm volatile("" ::: "memory");
        const bool bad = flag[0] != 0u;
        if (lane < 32) {
            const unsigned long long* slot = (const unsigned long long*)xbuf + (size_t)(u.pm * BM + row) * 4; float mt[4], m2[4]; float ms = 0.f;
#pragma unroll
            for (int t = 0; t < 4; ++t) { if (t < ntn) { const unsigned long long w = __hip_atomic_load(slot + t, __ATOMIC_RELAXED, __HIP_MEMORY_SCOPE_AGENT); mt[t] = __uint_as_float((unsigned)w); m2[t] = __uint_as_float((unsigned)(w >> 32)); } else { mt[t] = 0.f; m2[t] = 0.f; } ms += mt[t]; }
            const float mean = ms / (float)ntn; float q = 0.f;
#pragma unroll
            for (int t = 0; t < 4; ++t) if (t < ntn) { const float dm = mt[t] - mean; q += m2[t] + 256.0f * dm * dm; }
            S[row] = (f32x2v){mean, 1.0f / sqrtf(q / (256.0f * (float)ntn) + eps)};
        }
        asm volatile("s_waitcnt lgkmcnt(0)" ::: "memory"); __builtin_amdgcn_s_barrier(); asm volatile("" ::: "memory");
        return bad;
    }
};
struct EpiLnRes {
    static constexpr bool PERM = false, AFTER_DRAIN = true, MID = false;
    const float* base; float* out; int ldc; const float* bias; PanelStats st; unsigned poison;
    __device__ __forceinline__ void refuse(size_t i0, size_t stride, int M, int N) const { const float q = __builtin_nanf(""); for (size_t i = i0; i < (size_t)M * N; i += stride) out[(i / N) * ldc + i % N] = q;
        if (i0 == 0) { unsigned expect = 0u; __hip_atomic_compare_exchange_strong(st.tmo + 1, &expect, 0x7f0u, __ATOMIC_RELAXED, __ATOMIC_RELAXED, __HIP_MEMORY_SCOPE_AGENT); __hip_atomic_store(st.tmo, 1u, __ATOMIC_RELAXED, __HIP_MEMORY_SCOPE_AGENT); } }
    __device__ __forceinline__ void fused(f32x4 (&acc)[2][2][4][2], const Unit& u, int wr, int wc, int fr, int fq, PG8_LAS unsigned char* lds, int wid, int lane) const {
        typedef float f32x2v __attribute__((ext_vector_type(2)));
        const PG8_LAS f32x2v* S = (const PG8_LAS f32x2v*)(lds + 8192);
        const int col0 = u.pn * BM + wc * 32 + 4 * fq;
#pragma unroll
        for (int bj = 0; bj < 2; ++bj)
#pragma unroll
            for (int n = 0; n < 2; ++n) { const f32x4 bv = bias ? *(const f32x4*)(bias + col0 + bj * HALF + n * 16) : (f32x4){0.f, 0.f, 0.f, 0.f};
#pragma unroll
                for (int ai = 0; ai < 2; ++ai)
#pragma unroll
                    for (int m = 0; m < 4; ++m) acc[ai][bj][m][n] += bv; }
        const bool bad = st.run(acc, u, wr, wc, fr, fq, lds, wid, lane) || poison != 0u;
        const float qnan = __builtin_nanf("");
#pragma unroll
        for (int ai = 0; ai < 2; ++ai)
#pragma unroll
            for (int m = 0; m < 4; ++m) { const int r = ai * HALF + wr * 64 + m * 16 + fr; const f32x2v sr = S[r]; const size_t off = (size_t)(u.pm * BM + r) * ldc + col0;
#pragma unroll
                for (int bj = 0; bj < 2; ++bj)
#pragma unroll
                    for (int n = 0; n < 2; ++n) { const f32x4 bs = *(const f32x4*)(base + off + bj * HALF + n * 16); f32x4 o = bs + (acc[ai][bj][m][n] - sr.x) * sr.y;
                        if (bad) o = (f32x4){qnan, qnan, qnan, qnan}; *(f32x4*)(out + off + bj * HALF + n * 16) = o; }
                asm volatile("" ::: "memory"); }
    }
};
struct EpiLnResLn {
    static constexpr bool PERM = false, AFTER_DRAIN = true, MID = false;
    const float* base; float* out; bf16_t* xn; int ldc; const float* bias; PanelStats st1, st2; unsigned poison;
    __device__ __forceinline__ void refuse(size_t i0, size_t stride, int M, int N) const { const float q = __builtin_nanf(""); for (size_t i = i0; i < (size_t)M * N; i += stride) { const size_t o = (i / N) * ldc + i % N; out[o] = q; xn[o] = (bf16_t)0x7fc0u; }
        if (i0 == 0) { unsigned expect = 0u; __hip_atomic_compare_exchange_strong(st1.tmo + 1, &expect, 0x7f0u, __ATOMIC_RELAXED, __ATOMIC_RELAXED, __HIP_MEMORY_SCOPE_AGENT); __hip_atomic_store(st1.tmo, 1u, __ATOMIC_RELAXED, __HIP_MEMORY_SCOPE_AGENT); } }
    __device__ __forceinline__ void fused(f32x4 (&acc)[2][2][4][2], const Unit& u, int wr, int wc, int fr, int fq, PG8_LAS unsigned char* lds, int wid, int lane) const {
        typedef float f32x2v __attribute__((ext_vector_type(2))); typedef unsigned u32x2v __attribute__((ext_vector_type(2)));
        const PG8_LAS f32x2v* S = (const PG8_LAS f32x2v*)(lds + 8192);
        const int col0 = u.pn * BM + wc * 32 + 4 * fq;
#pragma unroll
        for (int bj = 0; bj < 2; ++bj)
#pragma unroll
            for (int n = 0; n < 2; ++n) { const f32x4 bv = bias ? *(const f32x4*)(bias + col0 + bj * HALF + n * 16) : (f32x4){0.f, 0.f, 0.f, 0.f};
#pragma unroll
                for (int ai = 0; ai < 2; ++ai)
#pragma unroll
                    for (int m = 0; m < 4; ++m) acc[ai][bj][m][n] += bv; }
        bool bad = st1.run(acc, u, wr, wc, fr, fq, lds, wid, lane) || poison != 0u;
        const float qnan = __builtin_nanf("");
#pragma unroll
        for (int ai = 0; ai < 2; ++ai)
#pragma unroll
            for (int m = 0; m < 4; ++m) { const int r = ai * HALF + wr * 64 + m * 16 + fr; const f32x2v sr = S[r]; const size_t off = (size_t)(u.pm * BM + r) * ldc + col0;
#pragma unroll
                for (int bj = 0; bj < 2; ++bj)
#pragma unroll
                    for (int n = 0; n < 2; ++n) { const f32x4 bs = *(const f32x4*)(base + off + bj * HALF + n * 16); acc[ai][bj][m][n] = bs + (acc[ai][bj][m][n] - sr.x) * sr.y; }
                asm volatile("" : "+v"(acc[ai][0][m][0]), "+v"(acc[ai][0][m][1]), "+v"(acc[ai][1][m][0]), "+v"(acc[ai][1][m][1]));
                if (m & 1) asm volatile("" ::: "memory"); }
        const bool bad1 = bad;
        bad = st2.run(acc, u, wr, wc, fr, fq, lds, wid, lane) || bad;
#pragma unroll
        for (int ai = 0; ai < 2; ++ai)
#pragma unroll
            for (int m = 0; m < 4; ++m) { const int r = ai * HALF + wr * 64 + m * 16 + fr; const f32x2v sr = S[r]; const size_t off = (size_t)(u.pm * BM + r) * ldc + col0;
#pragma unroll
                for (int bj = 0; bj < 2; ++bj)
#pragma unroll
                    for (int n = 0; n < 2; ++n) { const f32x4 x1 = acc[ai][bj][m][n]; *(f32x4*)(out + off + bj * HALF + n * 16) = bad1 ? (f32x4){qnan, qnan, qnan, qnan} : x1;
                        const f32x4 o = (x1 - sr.x) * sr.y; u32x2v w; w.x = cvt_pk_bf16(o[0], o[1]); w.y = cvt_pk_bf16(o[2], o[3]);
                        if (bad) { w.x = 0x7fc07fc0u; w.y = 0x7fc07fc0u; } *(u32x2v*)(xn + off + bj * HALF + n * 16) = w; }
                asm volatile("" ::: "memory"); }
    }
};

template <class Epi, class Sched, bool STAMP = false>
__device__ __forceinline__ void gemm_phase(PG8_LAS unsigned char* lds, const Gemm g, const Sched& S, const Epi& E, unsigned long long* stamps = nullptr) {
    int tid_ = threadIdx.x; asm volatile("" : "+v"(tid_));
    const int tid = tid_, wid = __builtin_amdgcn_readfirstlane(tid >> 6), lane = tid & 63, wr = wid >> 2, wc = wid & 3, fr = lane & 15, fq = lane >> 4;
    const int K = g.K, nt = K / BK;
    int ts_lo = 0, ts_hi = 0, nts = 0; const unsigned long long rt_entry = STAMP ? (unsigned long long)wall_clock64() : 0ull;
#define PG8_STAMP() do { if (STAMP && wid == 0 && nts < 64) { const unsigned long long _c = (unsigned long long)clock64(); \
        ts_lo = (lane == nts) ? (int)(unsigned)_c : ts_lo; ts_hi = (lane == nts) ? (int)(unsigned)(_c >> 32) : ts_hi; ++nts; } } while (0)
    PG8_STAMP();
    unsigned voffA[2], voffB[2];
#pragma unroll
    for (int i = 0; i < 2; ++i) { int R, C; stage_rc(tid * 16 + i * 8192, R, C); const int Rb = Epi::PERM ? ((R & ~31) + perm32(R & 31)) : R;
        voffA[i] = (unsigned)(R * K + C) * 2u; voffB[i] = (unsigned)(Rb * K + C) * 2u; }
    const size_t kstep = (size_t)(BK * 2);
    const size_t hstep = (size_t)HALF * K * 2;
    const size_t tstep = 2 * hstep;
    const unsigned ldsw = (unsigned)wid * 1024u;
    const int aoff = lds_byte(wr * 64 + fr, fq * 8), boff = lds_byte(wc * 32 + fr, fq * 8);
#define PG8_SA(b, h) (((b) * 2 + (h)) * HTB)
#define PG8_SB(b, h) ((4 + (b) * 2 + (h)) * HTB)
#define PG8_STAGE(bufoff, gbase, voff) do { _Pragma("unroll") for (int _i = 0; _i < 2; ++_i) \
        __builtin_amdgcn_global_load_lds((const unsigned*)((const char*)(gbase) + (voff)[_i]), (PG8_LAS unsigned*)(lds + (bufoff) + ldsw + _i * 8192), 16, 0, 0); } while (0)
#define PG8_LDA(dst, b, h) do { _Pragma("unroll") for (int m = 0; m < 4; ++m) _Pragma("unroll") for (int k = 0; k < 2; ++k) dst[m][k] = *(const PG8_LAS bf16x8*)(lds + PG8_SA(b, h) + aoff + m * 2048 + k * 1024); } while (0)
#define PG8_LDB(dst, b, h) do { _Pragma("unroll") for (int n = 0; n < 2; ++n) _Pragma("unroll") for (int k = 0; k < 2; ++k) dst[n][k] = *(const PG8_LAS bf16x8*)(lds + PG8_SB(b, h) + boff + n * 2048 + k * 1024); } while (0)
#define PG8_MMA(ai, bj, At, Bt) do { __builtin_amdgcn_s_setprio(1); _Pragma("unroll") for (int m = 0; m < 4; ++m) _Pragma("unroll") for (int n = 0; n < 2; ++n) _Pragma("unroll") for (int k = 0; k < 2; ++k) \
        acc[ai][bj][m][n] = __builtin_amdgcn_mfma_f32_16x16x32_bf16(Bt[n][k], At[m][k], acc[ai][bj][m][n], 0, 0, 0); __builtin_amdgcn_s_setprio(0); } while (0)
#define PG8_WAIT_V(n) asm volatile("s_waitcnt vmcnt(" #n ")" ::: "memory")
#define PG8_WAIT_L(n) asm volatile("s_waitcnt lgkmcnt(" #n ")" ::: "memory")
#define PG8_BAR __builtin_amdgcn_s_barrier()
#define PG8_SCHED __builtin_amdgcn_sched_barrier(0)
    Unit cur, nxt; int ui = 0;
    if (!S.next(0, cur)) return;
    f32x4 acc[2][2][4][2];
#pragma unroll
    for (int a = 0; a < 2; ++a)
#pragma unroll
        for (int b = 0; b < 2; ++b)
#pragma unroll
            for (int m = 0; m < 4; ++m)
#pragma unroll
                for (int n = 0; n < 2; ++n) acc[a][b][m][n] = (f32x4){0.f, 0.f, 0.f, 0.f};
    bf16x8 At[4][2], B0[2][2], B1[2][2];
    const char* cA = (const char*)g.A + (size_t)cur.pm * tstep; const char* cB = (const char*)g.Bt + (size_t)cur.pn * tstep;
    S.a_ready(cur);
    PG8_STAGE(PG8_SB(0, 0), cB, voffB); PG8_STAGE(PG8_SA(0, 0), cA, voffA); PG8_STAGE(PG8_SB(0, 1), cB + hstep, voffB); PG8_STAGE(PG8_SA(0, 1), cA + hstep, voffA);
    if (wr == 1) PG8_BAR;
    PG8_WAIT_V(4); PG8_BAR;
    PG8_STAGE(PG8_SB(1, 0), cB + kstep, voffB); PG8_STAGE(PG8_SA(1, 0), cA + kstep, voffA); PG8_STAGE(PG8_SB(1, 1), cB + hstep + kstep, voffB);
    PG8_WAIT_V(6); PG8_BAR;
    PG8_STAMP();
    for (;;) {
        const bool has_next = S.next(ui + 1, nxt);
        const char* nA = has_next ? (const char*)g.A + (size_t)nxt.pm * tstep : cA; const char* nB = has_next ? (const char*)g.Bt + (size_t)nxt.pn * tstep : cB;
        for (int t = 0; t < nt; t += 2) {
            const bool last = (t == nt - 2);
            const char* a1 = cA + (size_t)(t + 1) * kstep;
            const char* a2 = last ? nA : cA + (size_t)(t + 2) * kstep; const char* b2 = last ? nB : cB + (size_t)(t + 2) * kstep;
            const char* a3 = a2 + kstep; const char* b3 = b2 + kstep;
            if (last && has_next) S.a_ready(nxt);
            if constexpr (Epi::MID) { if (t == 4 || t == 12) E.mid(acc, cur, t == 12 ? 1 : 0, wr, wc, fr, fq); }
            PG8_LDB(B0, 0, 0); PG8_SCHED; PG8_LDA(At, 0, 0); PG8_STAGE(PG8_SA(1, 1), a1 + hstep, voffA);
            PG8_WAIT_L(8); PG8_BAR; PG8_WAIT_L(0); PG8_MMA(0, 0, At, B0); PG8_BAR; PG8_SCHED;
            PG8_LDB(B1, 0, 1); PG8_STAGE(PG8_SB(0, 0), b2, voffB);
            PG8_BAR; PG8_WAIT_L(0); PG8_MMA(0, 1, At, B1); PG8_BAR;
            PG8_LDA(At, 0, 1); PG8_STAGE(PG8_SA(0, 0), a2, voffA);
            PG8_BAR; PG8_WAIT_L(0); PG8_MMA(1, 0, At, B0); PG8_BAR; PG8_SCHED;
            PG8_STAGE(PG8_SB(0, 1), b2 + hstep, voffB);
            PG8_WAIT_V(6); PG8_BAR; PG8_MMA(1, 1, At, B1); PG8_BAR;
            PG8_LDB(B0, 1, 0); PG8_SCHED; PG8_LDA(At, 1, 0); PG8_STAGE(PG8_SA(0, 1), a2 + hstep, voffA);
            PG8_WAIT_L(8); PG8_BAR; PG8_WAIT_L(0); PG8_MMA(0, 0, At, B0); PG8_BAR; PG8_SCHED;
            PG8_LDB(B1, 1, 1); PG8_STAGE(PG8_SB(1, 0), b3, voffB);
            PG8_BAR; PG8_WAIT_L(0); PG8_MMA(0, 1, At, B1); PG8_BAR;
            PG8_LDA(At, 1, 1); PG8_STAGE(PG8_SA(1, 0), a3, voffA);
            PG8_BAR; PG8_WAIT_L(0); PG8_MMA(1, 0, At, B0); PG8_BAR; PG8_SCHED;
            PG8_STAGE(PG8_SB(1, 1), b3 + hstep, voffB);
            PG8_WAIT_V(6); PG8_BAR; PG8_MMA(1, 1, At, B1); PG8_BAR;
        }
        PG8_STAMP();
        if constexpr (!Epi::AFTER_DRAIN) { E(acc, cur, wr, wc, fr, fq); S.done(cur); }
        PG8_STAMP();
        if (!has_next) break;
#pragma unroll
        for (int a = 0; a < 2; ++a)
#pragma unroll
            for (int b = 0; b < 2; ++b)
#pragma unroll
                for (int m = 0; m < 4; ++m)
#pragma unroll
                    for (int n = 0; n < 2; ++n) acc[a][b][m][n] = (f32x4){0.f, 0.f, 0.f, 0.f};
        cur = nxt; cA = nA; cB = nB; ++ui;
    }
    PG8_WAIT_V(0);
    if (wr == 0) PG8_BAR;
    PG8_BAR;
    if constexpr (Epi::AFTER_DRAIN) { E.fused(acc, cur, wr, wc, fr, fq, lds, wid, lane); S.done(cur); }
    PG8_STAMP();
    if (STAMP && wid == 0) { stamps[lane] = lane < nts ? (((unsigned long long)(unsigned)ts_hi << 32) | (unsigned)ts_lo) : 0ull;
        if (lane == 62) stamps[62] = rt_entry; if (lane == 63) stamps[63] = (unsigned long long)wall_clock64(); }
#undef PG8_STAMP
#undef PG8_SA
#undef PG8_SB
#undef PG8_STAGE
#undef PG8_LDA
#undef PG8_LDB
#undef PG8_MMA
#undef PG8_WAIT_V
#undef PG8_WAIT_L
#undef PG8_BAR
#undef PG8_SCHED
}
}

typedef unsigned short bf16_t;
typedef unsigned u32x4 __attribute__((ext_vector_type(4)));
typedef unsigned u32x2 __attribute__((ext_vector_type(2)));
typedef float f32x4 __attribute__((ext_vector_type(4)));
typedef short bf16x8 __attribute__((ext_vector_type(8)));
#define LAS __attribute__((address_space(3)))

constexpr int M = 65536, D = 1024, SEQ = 8192, NIN = 4864, NPA = 1792, NGT = 3072, FF = 2816, NUP = 5632, DEPTH = 4, MH = 32768;
constexpr size_t MiB = (size_t)1 << 20;
constexpr size_t OFF_ROPE = 0, OFF_W = 8 * MiB, OFF_XB = 130 * MiB, OFF_R = 258 * MiB;
constexpr size_t W_IN = 0, W_CAT = W_IN + (size_t)4864 * 1024, W_O = W_CAT + (size_t)1024 * 1024, W_UP = W_O + (size_t)1024 * 1024,
                 W_DOWN = W_UP + (size_t)5632 * 1024, W_POOL = W_DOWN + (size_t)1024 * 2816, W_LAYER = W_POOL + 16384;
constexpr size_t OFF_PA = OFF_R, OFF_GT = OFF_R + 224 * MiB, OFF_MG = OFF_R, OFF_UP = OFF_R, OFF_H = OFF_R + 352 * MiB;
constexpr size_t WS_NEED = OFF_R + 704 * MiB;
constexpr int LDS_BYTES = 144 * 1024;
#ifndef PHM
#define PHM 1023
#endif
constexpr float ALPHA = 1.681792830507429f;
constexpr float LN_EPS = 1e-5f;

__device__ __forceinline__ float bflo(unsigned w) { return __uint_as_float(w << 16); }
__device__ __forceinline__ float bfhi(unsigned w) { return __uint_as_float(w & 0xffff0000u); }
__device__ __forceinline__ unsigned pkbf(float lo, float hi) { return pg8::cvt_pk_bf16(lo, hi); }
__device__ __forceinline__ float fast_sigmoid(float x) { return __builtin_amdgcn_rcpf(1.0f + __expf(-x)); }

struct EpiProj {
    static constexpr bool PERM = true, AFTER_DRAIN = false, MID = false;
    bf16_t* pa; bf16_t* gt;
    __device__ __forceinline__ void operator()(const f32x4 (&acc)[2][2][4][2], const pg8::Unit& u, int wr, int wc, int fr, int fq) const {
        const int row0 = u.pm * 256 + wr * 64 + fr; const bool sg = u.pn >= 7;
        bf16_t* base = sg ? gt + (u.pn - 7) * 256 : pa + u.pn * 256; const int ldc = sg ? NGT : NPA;
        const int col0 = wc * 32 + 8 * fq;
#pragma unroll
        for (int ai = 0; ai < 2; ++ai)
#pragma unroll
            for (int m = 0; m < 4; ++m) { bf16_t* rowp = base + (size_t)(row0 + ai * 128 + m * 16) * ldc + col0;
#pragma unroll
                for (int bj = 0; bj < 2; ++bj) { f32x4 v0 = acc[ai][bj][m][0], v1 = acc[ai][bj][m][1];
                    if (sg) {
#pragma unroll
                        for (int j = 0; j < 4; ++j) { v0[j] = fast_sigmoid(v0[j]); v1[j] = fast_sigmoid(v1[j]); } }
                    u32x4 w; w.x = pkbf(v0[0], v0[1]); w.y = pkbf(v0[2], v0[3]); w.z = pkbf(v1[0], v1[1]); w.w = pkbf(v1[2], v1[3]);
                    *(u32x4*)(rowp + bj * 128) = w; } }
    }
};
struct EpiBf {
    static constexpr bool PERM = true, AFTER_DRAIN = false, MID = false;
    bf16_t* O; int ldc;
    __device__ __forceinline__ void operator()(const f32x4 (&acc)[2][2][4][2], const pg8::Unit& u, int wr, int wc, int fr, int fq) const {
        const int row0 = u.pm * 256 + wr * 64 + fr; const int col0 = u.pn * 256 + wc * 32 + 8 * fq;
#pragma unroll
        for (int ai = 0; ai < 2; ++ai)
#pragma unroll
            for (int m = 0; m < 4; ++m) { bf16_t* rowp = O + (size_t)(row0 + ai * 128 + m * 16) * ldc + col0;
#pragma unroll
                for (int bj = 0; bj < 2; ++bj) { const f32x4 v0 = acc[ai][bj][m][0], v1 = acc[ai][bj][m][1];
                    u32x4 w; w.x = pkbf(v0[0], v0[1]); w.y = pkbf(v0[2], v0[3]); w.z = pkbf(v1[0], v1[1]); w.w = pkbf(v1[2], v1[3]);
                    *(u32x4*)(rowp + bj * 128) = w; } }
    }
};
struct EpiMerge {
    static constexpr bool PERM = true, AFTER_DRAIN = false, MID = true;
    const bf16_t* gt; bf16_t* O;
    __device__ __forceinline__ void mid(f32x4 (&acc)[2][2][4][2], const pg8::Unit& u, int which, int wr, int wc, int fr, int fq) const {
        const char* gb = (const char*)gt;
        const unsigned off = ((unsigned)(u.pm * 256 + wr * 64 + fr) * (unsigned)NGT + (unsigned)(which * 1024 + u.pn * 256 + wc * 32 + 8 * fq)) * 2u;
#pragma unroll
        for (int ai = 0; ai < 2; ++ai)
#pragma unroll
            for (int m = 0; m < 4; ++m) { const unsigned o = off + (unsigned)((ai * 128 + m * 16) * NGT * 2);
#pragma unroll
                for (int bj = 0; bj < 2; ++bj) { const u32x4 a = *(const u32x4*)(gb + o + bj * 256), b = *(const u32x4*)(gb + o + 2048 + bj * 256);
#pragma unroll
                    for (int n = 0; n < 2; ++n) { const unsigned a0 = n ? a.z : a.x, a1 = n ? a.w : a.y, b0 = n ? b.z : b.x, b1 = n ? b.w : b.y;
                        f32x4 r; r[0] = bflo(a0) * __builtin_amdgcn_rcpf(fmaxf(bflo(b0), 1e-30f)); r[1] = bfhi(a0) * __builtin_amdgcn_rcpf(fmaxf(bfhi(b0), 1e-30f));
                        r[2] = bflo(a1) * __builtin_amdgcn_rcpf(fmaxf(bflo(b1), 1e-30f)); r[3] = bfhi(a1) * __builtin_amdgcn_rcpf(fmaxf(bfhi(b1), 1e-30f));
                        acc[ai][bj][m][n] *= r; } }
                asm volatile("" ::: "memory"); }
    }
    __device__ __forceinline__ void operator()(const f32x4 (&acc)[2][2][4][2], const pg8::Unit& u, int wr, int wc, int fr, int fq) const {
        const int row0 = u.pm * 256 + wr * 64 + fr; const int col0 = u.pn * 256 + wc * 32 + 8 * fq;
        const bf16_t* g2 = gt + 2048;
#pragma unroll
        for (int ai = 0; ai < 2; ++ai)
#pragma unroll
            for (int m = 0; m < 4; ++m) { const size_t r = (size_t)(row0 + ai * 128 + m * 16);
#pragma unroll
                for (int bj = 0; bj < 2; ++bj) { const u32x4 a = *(const u32x4*)(g2 + r * NGT + col0 + bj * 128);
                    const f32x4 v0 = acc[ai][bj][m][0], v1 = acc[ai][bj][m][1];
                    u32x4 w; w.x = pkbf(v0[0] * bflo(a.x), v0[1] * bfhi(a.x)); w.y = pkbf(v0[2] * bflo(a.y), v0[3] * bfhi(a.y));
                    w.z = pkbf(v1[0] * bflo(a.z), v1[1] * bfhi(a.z)); w.w = pkbf(v1[2] * bflo(a.w), v1[3] * bfhi(a.w));
                    *(u32x4*)(O + r * D + col0 + bj * 128) = w; } }
    }
};
struct EpiRes {
    static constexpr bool PERM = false, AFTER_DRAIN = false, MID = false;
    const float* res; float* out;
    __device__ __forceinline__ void operator()(const f32x4 (&acc)[2][2][4][2], const pg8::Unit& u, int wr, int wc, int fr, int fq) const {
        const int row0 = u.pm * 256 + wr * 64 + fr, col0 = u.pn * 256 + wc * 32 + 4 * fq;
#pragma unroll
        for (int ai = 0; ai < 2; ++ai)
#pragma unroll
            for (int m = 0; m < 4; ++m) { const size_t off = (size_t)(row0 + ai * 128 + m * 16) * D + col0;
#pragma unroll
                for (int bj = 0; bj < 2; ++bj)
#pragma unroll
                    for (int n = 0; n < 2; ++n) { const f32x4 bs = *(const f32x4*)(res + off + bj * 128 + n * 16);
                        *(f32x4*)(out + off + bj * 128 + n * 16) = bs * ALPHA + acc[ai][bj][m][n]; }
                asm volatile("" ::: "memory"); }
    }
};

__device__ __forceinline__ float wave_sum(float v) {
#pragma unroll
    for (int o = 1; o < 64; o <<= 1) v += __shfl_xor(v, o);
    return v;
}
__device__ __forceinline__ void transpose_item(const float* W, int N, bf16_t* WT, int pitch, int koff, LAS float* scr, int item, int lane) {
    const int nblk = N / 32, kb = item / nblk, nb = item % nblk, k0 = 64 * kb, n0 = 32 * nb;
#pragma unroll 8
    for (int i = 0; i < 32; ++i) { const int kk = 2 * i + (lane >> 5); scr[kk * 33 + (lane & 31)] = W[(size_t)(k0 + kk) * N + n0 + (lane & 31)]; }
    asm volatile("s_waitcnt lgkmcnt(0)" ::: "memory");
    const int c = lane & 7;
#pragma unroll
    for (int j = 0; j < 4; ++j) { const int n = (lane >> 3) + 8 * j; const LAS float* s = scr + (8 * c) * 33 + n;
        u32x4 o; o.x = pkbf(s[0 * 33], s[1 * 33]); o.y = pkbf(s[2 * 33], s[3 * 33]); o.z = pkbf(s[4 * 33], s[5 * 33]); o.w = pkbf(s[6 * 33], s[7 * 33]);
        *(u32x4*)(WT + (size_t)(n0 + n) * pitch + koff + k0 + 8 * c) = o; }
    asm volatile("s_waitcnt lgkmcnt(0)" ::: "memory");
}

struct Args { const float* in[18]; float* out; unsigned char* ws; double inv_freq[8]; };

__device__ __forceinline__ void prologue_phase(const Args& a, unsigned char* lds_g) {
    int tid = threadIdx.x; asm volatile("" : "+v"(tid)); const int lane = tid & 63, wave = __builtin_amdgcn_readfirstlane(tid >> 6);
    LAS float* scr = (LAS float*)((LAS unsigned char*)lds_g + wave * 16384);
    const int gw = blockIdx.x * 8 + wave, NGW = gridDim.x * 8;
    constexpr int I_IN = 16 * 152, I_A = 4 * 32, I_B = 8 * 32, I_C = 4 * 32, I_O = 16 * 32, I_UP = 16 * 176, I_DN = 44 * 32, I_PL = 8;
    constexpr int I_LAYER = I_IN + I_A + I_B + I_C + I_O + I_UP + I_DN + I_PL;
    bf16_t* Wb = (bf16_t*)(a.ws + OFF_W);
    for (int it = gw; it < DEPTH * I_LAYER; it += NGW) {
        const int l = it / I_LAYER; int r = it % I_LAYER; bf16_t* Wl = Wb + (size_t)l * W_LAYER;
        if (r < I_IN) { transpose_item(a.in[2] + (size_t)l * 1024 * 4864, 4864, Wl + W_IN, 1024, 0, scr, r, lane); continue; } r -= I_IN;
        if (r < I_A) { transpose_item(a.in[7] + (size_t)l * 256 * 1024, 1024, Wl + W_CAT, 1024, 0, scr, r, lane); continue; } r -= I_A;
        if (r < I_B) { transpose_item(a.in[8] + (size_t)l * 512 * 1024, 1024, Wl + W_CAT, 1024, 256, scr, r, lane); continue; } r -= I_B;
        if (r < I_C) { transpose_item(a.in[9] + (size_t)l * 256 * 1024, 1024, Wl + W_CAT, 1024, 768, scr, r, lane); continue; } r -= I_C;
        if (r < I_O) { transpose_item(a.in[10] + (size_t)l * 1024 * 1024, 1024, Wl + W_O, 1024, 0, scr, r, lane); continue; } r -= I_O;
        if (r < I_UP) { transpose_item(a.in[13] + (size_t)l * 1024 * 5632, 5632, Wl + W_UP, 1024, 0, scr, r, lane); continue; } r -= I_UP;
        if (r < I_DN) { transpose_item(a.in[15] + (size_t)l * 2816 * 1024, 1024, Wl + W_DOWN, 2816, 0, scr, r, lane); continue; } r -= I_DN;
        { const int g = r >> 1; transpose_item(a.in[3] + (size_t)l * 16384 + g * 4096, 64, Wl + W_POOL + g * 4096, 64, 0, scr, r & 1, lane); }
    }
    { const f32x4* x4 = (const f32x4*)a.in[0]; u32x4* o = (u32x4*)(a.ws + OFF_XB);
      const size_t n8 = (size_t)M * D / 8, gs = (size_t)gridDim.x * 512;
      for (size_t i = (size_t)blockIdx.x * 512 + tid; i < n8; i += gs) { const f32x4 p = x4[2 * i], q = x4[2 * i + 1];
          u32x4 w; w.x = pkbf(p[0], p[1]); w.y = pkbf(p[2], p[3]); w.z = pkbf(q[0], q[1]); w.w = pkbf(q[2], q[3]); o[i] = w; } }
    { float* tab = (float*)(a.ws + OFF_ROPE); const int* pos = (const int*)a.in[1];
      const size_t n = (size_t)M * 8, gs = (size_t)gridDim.x * 512;
      for (size_t i = (size_t)blockIdx.x * 512 + tid; i < n; i += gs) { const int m = (int)(i >> 3), f = (int)(i & 7);
          const double ang = (double)pos[m] * a.inv_freq[f]; const double rev = ang * 0.15915494309189533577; const float fr = (float)(rev - floor(rev));
          tab[(size_t)m * 16 + f] = __builtin_amdgcn_cosf(fr); tab[(size_t)m * 16 + 8 + f] = __builtin_amdgcn_sinf(fr); } }
}

__device__ __forceinline__ void mix_phase(const Args& a, unsigned char* ws, int l, unsigned char* lds_g) {
    int tid = threadIdx.x; asm volatile("" : "+v"(tid)); const int lane = tid & 63, wave = __builtin_amdgcn_readfirstlane(tid >> 6);
    const bf16_t* PA = (const bf16_t*)(ws + OFF_PA); bf16_t* OC = (bf16_t*)(ws + OFF_XB);
    const float* rope = (const float*)(ws + OFF_ROPE);
    const bf16_t* WPT = (const bf16_t*)(ws + OFF_W) + (size_t)l * W_LAYER + W_POOL;
    const float* pscale = a.in[4] + l * 256; const float* sinks = a.in[5] + l * 8; const float* convw = a.in[6] + l * 768;
    LAS unsigned char* lds = (LAS unsigned char*)lds_g;
    constexpr int KS_PITCH = 144, VT_PITCH = 528, VT_OFF = 256 * 144, US_PITCH = 528;
    const int fr = lane & 15, fq = lane >> 4;
    for (int item = blockIdx.x; item < 512; item += gridDim.x) {
        const int blk = item & 63; const int tok0 = item * 128;
        for (int kvh = 0; kvh < 2; ++kvh) {
            __syncthreads();
            { const int row = tid >> 1, half = tid & 1; const int token = tok0 - 128 + row; const bool valid = (blk > 0) || (row >= 128);
              u32x4 kc[4], vc[4];
#pragma unroll
              for (int c = 0; c < 4; ++c) { kc[c] = (u32x4){0u, 0u, 0u, 0u}; vc[c] = (u32x4){0u, 0u, 0u, 0u}; }
              if (valid) { const bf16_t* kp = PA + (size_t)token * NPA + 768 + kvh * 64 + half * 32; const bf16_t* vp = kp + 128;
#pragma unroll
                  for (int c = 0; c < 4; ++c) { kc[c] = *(const u32x4*)(kp + c * 8); vc[c] = *(const u32x4*)(vp + c * 8); }
                  if (half == 0) { const f32x4* rt = (const f32x4*)(rope + (size_t)token * 16); const f32x4 c0 = rt[0], c1 = rt[1], s0 = rt[2], s1 = rt[3];
                      const u32x4 x1 = kc[0], x2 = kc[1]; u32x4 y1, y2;
#pragma unroll
                      for (int e = 0; e < 4; ++e) { const float cl = e < 2 ? c0[2 * e] : c1[2 * e - 4], ch = e < 2 ? c0[2 * e + 1] : c1[2 * e - 3];
                          const float sl = e < 2 ? s0[2 * e] : s1[2 * e - 4], sh = e < 2 ? s0[2 * e + 1] : s1[2 * e - 3];
                          const float a1l = bflo(x1[e]), a1h = bfhi(x1[e]), a2l = bflo(x2[e]), a2h = bfhi(x2[e]);
                          y1[e] = pkbf(a1l * cl - a2l * sl, a1h * ch - a2h * sh); y2[e] = pkbf(a2l * cl + a1l * sl, a2h * ch + a1h * sh); }
                      kc[0] = y1; kc[1] = y2; } }
#pragma unroll
              for (int c = 0; c < 4; ++c) *(LAS u32x4*)(lds + row * KS_PITCH + (half * 32 + c * 8) * 2) = kc[c];
#pragma unroll
              for (int c = 0; c < 4; ++c)
#pragma unroll
                  for (int e = 0; e < 4; ++e) { const int d = half * 32 + c * 8 + 2 * e;
                      *(LAS unsigned short*)(lds + VT_OFF + d * VT_PITCH + row * 2) = (unsigned short)(vc[c][e] & 0xffffu);
                      *(LAS unsigned short*)(lds + VT_OFF + (d + 1) * VT_PITCH + row * 2) = (unsigned short)(vc[c][e] >> 16); }
            }
            __syncthreads();
            const int head = kvh * 4 + (wave >> 1); const float sink = sinks[head];
            for (int tile = 0; tile < 4; ++tile) {
                const int i0 = (wave & 1) * 64 + tile * 16; const int qtoken = tok0 + i0 + fr;
                const bf16_t* qp = PA + (size_t)qtoken * NPA + 256 + head * 64 + fq * 8;
                u32x4 q0 = *(const u32x4*)qp, q1 = *(const u32x4*)(qp + 32);
                { u32x4 other;
#pragma unroll
                  for (int e = 0; e < 4; ++e) other[e] = (unsigned)__shfl_xor((int)q0[e], 16);
                  const f32x4* rt = (const f32x4*)(rope + (size_t)qtoken * 16); const f32x4 c0 = rt[0], c1 = rt[1], s0 = rt[2], s1 = rt[3];
                  u32x4 y;
#pragma unroll
                  for (int e = 0; e < 4; ++e) { const float cl = e < 2 ? c0[2 * e] : c1[2 * e - 4], ch = e < 2 ? c0[2 * e + 1] : c1[2 * e - 3];
                      const float sl = e < 2 ? s0[2 * e] : s1[2 * e - 4], sh = e < 2 ? s0[2 * e + 1] : s1[2 * e - 3];
                      const float ml = bflo(q0[e]), mh = bfhi(q0[e]), ol = bflo(other[e]), oh = bfhi(other[e]);
                      float rl, rh;
                      if (fq == 0) { rl = ml * cl - ol * sl; rh = mh * ch - oh * sh; }
                      else if (fq == 1) { rl = ml * cl + ol * sl; rh = mh * ch + oh * sh; }
                      else { rl = ml; rh = mh; }
                      y[e] = pkbf(rl * 0.125f, rh * 0.125f); }
                  q0 = y;
#pragma unroll
                  for (int e = 0; e < 4; ++e) q1[e] = pkbf(bflo(q1[e]) * 0.125f, bfhi(q1[e]) * 0.125f); }
                const bf16x8 qf0 = __builtin_bit_cast(bf16x8, q0), qf1 = __builtin_bit_cast(bf16x8, q1);
                f32x4 s[9];
#pragma unroll
                for (int kb = 0; kb < 9; ++kb) { const int krow = i0 + kb * 16 + fr;
                    const bf16x8 k0 = *(const LAS bf16x8*)(lds + krow * KS_PITCH + fq * 16), k1 = *(const LAS bf16x8*)(lds + krow * KS_PITCH + 64 + fq * 16);
                    f32x4 c = (f32x4){0.f, 0.f, 0.f, 0.f};
                    c = __builtin_amdgcn_mfma_f32_16x16x32_bf16(k0, qf0, c, 0, 0, 0);
                    c = __builtin_amdgcn_mfma_f32_16x16x32_bf16(k1, qf1, c, 0, 0, 0);
                    s[kb] = c; }
                float mx = sink;
#pragma unroll
                for (int kb = 0; kb < 9; ++kb)
#pragma unroll
                    for (int j = 0; j < 4; ++j) { const int rel = kb * 16 + fq * 4 + j - fr; const int jk = i0 + kb * 16 + fq * 4 + j;
                        const bool ok = (rel > 0) && (rel <= 128) && ((blk > 0) || (jk >= 128));
                        const float v = ok ? s[kb][j] : -1e30f; s[kb][j] = v; mx = fmaxf(mx, v); }
                mx = fmaxf(mx, __shfl_xor(mx, 16)); mx = fmaxf(mx, __shfl_xor(mx, 32));
                float sum = 0.f;
#pragma unroll
                for (int kb = 0; kb < 9; ++kb)
#pragma unroll
                    for (int j = 0; j < 4; ++j) { const float p = __expf(s[kb][j] - mx); s[kb][j] = p; sum += p; }
                sum += __shfl_xor(sum, 16); sum += __shfl_xor(sum, 32);
                sum += __expf(sink - mx);
                const float inv = 1.0f / sum;
                f32x4 o[4];
#pragma unroll
                for (int nb = 0; nb < 4; ++nb) o[nb] = (f32x4){0.f, 0.f, 0.f, 0.f};
#pragma unroll
                for (int kk = 0; kk < 5; ++kk) {
                    u32x4 pw; pw.x = pkbf(s[2 * kk][0], s[2 * kk][1]); pw.y = pkbf(s[2 * kk][2], s[2 * kk][3]);
                    if (kk < 4) { pw.z = pkbf(s[2 * kk + 1][0], s[2 * kk + 1][1]); pw.w = pkbf(s[2 * kk + 1][2], s[2 * kk + 1][3]); } else { pw.z = 0u; pw.w = 0u; }
                    const bf16x8 pf = __builtin_bit_cast(bf16x8, pw);
#pragma unroll
                    for (int nb = 0; nb < 4; ++nb) { const int d = nb * 16 + fr;
                        const LAS unsigned char* vb = lds + VT_OFF + d * VT_PITCH + (i0 + 32 * kk + 4 * fq) * 2;
                        u32x2 lo = *(const LAS u32x2*)vb; u32x2 hi = (u32x2){0u, 0u};
                        if (kk < 4) hi = *(const LAS u32x2*)(vb + 32);
                        u32x4 vw; vw.x = lo.x; vw.y = lo.y; vw.z = hi.x; vw.w = hi.y;
                        o[nb] = __builtin_amdgcn_mfma_f32_16x16x32_bf16(__builtin_bit_cast(bf16x8, vw), pf, o[nb], 0, 0, 0); } }
                bf16_t* op = OC + (size_t)qtoken * D + 256 + head * 64 + fq * 4;
#pragma unroll
                for (int nb = 0; nb < 4; ++nb) { u32x2 w; w.x = pkbf(o[nb][0] * inv, o[nb][1] * inv); w.y = pkbf(o[nb][2] * inv, o[nb][3] * inv); *(u32x2*)(op + nb * 16) = w; }
            }
        }
        __syncthreads();
        for (int ch = tid; ch < 143 * 32; ch += 512) { const int r = ch >> 5, c = ch & 31; const bool valid = (blk > 0) || (r >= 15);
            u32x4 v = (u32x4){0u, 0u, 0u, 0u};
            if (valid) v = *(const u32x4*)(PA + (size_t)(tok0 - 15 + r) * NPA + c * 8);
            *(LAS u32x4*)(lds + r * US_PITCH + c * 16) = v; }
        __syncthreads();
        {
            const int i = wave * 16 + fr; const int sidx = blk * 128 + i; const int token = tok0 + i;
#pragma unroll
            for (int g = 0; g < 4; ++g) { const int w = 2 << g; const float rc = 1.0f / (float)min(sidx + 1, w);
                bf16x8 pf[2];
#pragma unroll
                for (int ks = 0; ks < 2; ++ks) { const int cb = (g * 64 + ks * 32 + fq * 8) * 2;
                    float acc8[8];
#pragma unroll
                    for (int e = 0; e < 8; ++e) acc8[e] = 0.f;
                    for (int jj = 0; jj < w; ++jj) { const u32x4 v = *(const LAS u32x4*)(lds + (15 + i - jj) * US_PITCH + cb);
#pragma unroll
                        for (int e = 0; e < 4; ++e) { acc8[2 * e] += bflo(v[e]); acc8[2 * e + 1] += bfhi(v[e]); } }
                    const u32x4 self = *(const LAS u32x4*)(lds + (15 + i) * US_PITCH + cb);
                    u32x4 pw;
#pragma unroll
                    for (int e = 0; e < 4; ++e) pw[e] = pkbf(acc8[2 * e] * rc - bflo(self[e]), acc8[2 * e + 1] * rc - bfhi(self[e]));
                    pf[ks] = __builtin_bit_cast(bf16x8, pw); }
#pragma unroll
                for (int nb = 0; nb < 4; ++nb) { f32x4 c = (f32x4){0.f, 0.f, 0.f, 0.f};
#pragma unroll
                    for (int ks = 0; ks < 2; ++ks) { const bf16x8 wf = *(const bf16x8*)(WPT + g * 4096 + (nb * 16 + fr) * 64 + ks * 32 + fq * 8);
                        c = __builtin_amdgcn_mfma_f32_16x16x32_bf16(wf, pf[ks], c, 0, 0, 0); }
                    const int dcol = g * 64 + nb * 16 + fq * 4; const f32x4 sc = *(const f32x4*)(pscale + dcol);
                    u32x2 wv; wv.x = pkbf(c[0] * sc[0], c[1] * sc[1]); wv.y = pkbf(c[2] * sc[2], c[3] * sc[3]);
                    *(u32x2*)(OC + (size_t)token * D + dcol) = wv; } }
        }
        for (int ch = tid; ch < 128 * 32; ch += 512) { const int i = ch >> 5, c = (ch & 31) * 8; const int sidx = blk * 128 + i; const size_t token = (size_t)tok0 + i;
            float y[8];
#pragma unroll
            for (int e = 0; e < 8; ++e) y[e] = 0.f;
#pragma unroll
            for (int k = 0; k < 3; ++k) { const int back = 2 - k;
                if (sidx - back >= 0) { const bf16_t* p = PA + (token - back) * NPA; const u32x4 xv = *(const u32x4*)(p + 1024 + c), gv = *(const u32x4*)(p + 1536 + c);
                    const f32x4 w0 = *(const f32x4*)(convw + k * 256 + c), w1 = *(const f32x4*)(convw + k * 256 + c + 4);
#pragma unroll
                    for (int e = 0; e < 4; ++e) { const float wl = e < 2 ? w0[2 * e] : w1[2 * e - 4], wh = e < 2 ? w0[2 * e + 1] : w1[2 * e - 3];
                        y[2 * e] += wl * bflo(xv[e]) * bflo(gv[e]); y[2 * e + 1] += wh * bfhi(xv[e]) * bfhi(gv[e]); } } }
            const u32x4 gb = *(const u32x4*)(PA + token * NPA + 1280 + c);
            u32x4 o;
#pragma unroll
            for (int e = 0; e < 4; ++e) o[e] = pkbf(y[2 * e] * bflo(gb[e]), y[2 * e + 1] * bfhi(gb[e]));
            *(u32x4*)(OC + token * D + 768 + c) = o; }
    }
}

__device__ __forceinline__ void ln_phase(const float* pre, float* xout, bf16_t* xb, const float* g, const float* b) {
    int tid = threadIdx.x; asm volatile("" : "+v"(tid)); const int lane = tid & 63, wave = __builtin_amdgcn_readfirstlane(tid >> 6);
    const int gw = blockIdx.x * 8 + wave, NGW = gridDim.x * 8;
    f32x4 gv[4], bv[4];
#pragma unroll
    for (int j = 0; j < 4; ++j) { gv[j] = ((const f32x4*)g)[lane + 64 * j]; bv[j] = ((const f32x4*)b)[lane + 64 * j]; }
    for (int m = gw; m < M; m += NGW) {
        const f32x4* xr = (const f32x4*)(pre + (size_t)m * D) + lane;
        f32x4 v[4]; float s = 0.f;
#pragma unroll
        for (int j = 0; j < 4; ++j) { v[j] = xr[64 * j]; s += (v[j][0] + v[j][1]) + (v[j][2] + v[j][3]); }
        const float mean = wave_sum(s) * (1.f / D); float s2 = 0.f;
#pragma unroll
        for (int j = 0; j < 4; ++j) { v[j] = v[j] - mean; s2 += (v[j][0] * v[j][0] + v[j][1] * v[j][1]) + (v[j][2] * v[j][2] + v[j][3] * v[j][3]); }
        const float rstd = 1.f / sqrtf(wave_sum(s2) * (1.f / D) + LN_EPS);
        f32x4* o4 = (f32x4*)(xout + (size_t)m * D) + lane; u32x2* o2 = (u32x2*)(xb + (size_t)m * D) + lane;
#pragma unroll
        for (int j = 0; j < 4; ++j) { const f32x4 y = v[j] * rstd * gv[j] + bv[j]; o4[64 * j] = y; u32x2 w; w.x = pkbf(y[0], y[1]); w.y = pkbf(y[2], y[3]); o2[64 * j] = w; }
    }
}

__device__ __forceinline__ void act_phase(const Args& a, unsigned char* ws, int l, int hf) {
    const bf16_t* UP = (const bf16_t*)(ws + OFF_UP); bf16_t* H = (bf16_t*)(ws + OFF_H) + (size_t)hf * MH * FF;
    const float* cw = a.in[14] + (size_t)l * 3 * NUP;
    const int NCG = FF / 8, NCH = MH / 16;
    int tid = threadIdx.x; asm volatile("" : "+v"(tid));
    const size_t total = (size_t)NCG * NCH, gs = (size_t)gridDim.x * 512;
    for (size_t it = (size_t)blockIdx.x * 512 + tid; it < total; it += gs) {
        const int cg8 = (int)(it % NCG) * 8, t0 = (int)(it / NCG) * 16;
        float wa[3][8], wb[3][8];
#pragma unroll
        for (int k = 0; k < 3; ++k) { const f32x4 p0 = *(const f32x4*)(cw + k * NUP + cg8), p1 = *(const f32x4*)(cw + k * NUP + cg8 + 4);
            const f32x4 q0 = *(const f32x4*)(cw + k * NUP + FF + cg8), q1 = *(const f32x4*)(cw + k * NUP + FF + cg8 + 4);
#pragma unroll
            for (int e = 0; e < 4; ++e) { wa[k][e] = p0[e]; wa[k][4 + e] = p1[e]; wb[k][e] = q0[e]; wb[k][4 + e] = q1[e]; } }
        u32x4 a2 = (u32x4){0u, 0u, 0u, 0u}, a1 = a2, b2 = a2, b1 = a2;
        if ((t0 & (SEQ - 1)) != 0) { const bf16_t* p = UP + (size_t)(t0 - 2) * NUP + cg8; a2 = *(const u32x4*)p; b2 = *(const u32x4*)(p + FF); a1 = *(const u32x4*)(p + NUP); b1 = *(const u32x4*)(p + NUP + FF); }
        for (int tt = 0; tt < 16; ++tt) { const bf16_t* p = UP + (size_t)(t0 + tt) * NUP + cg8; const u32x4 a0 = *(const u32x4*)p, b0 = *(const u32x4*)(p + FF);
            u32x4 o;
#pragma unroll
            for (int e = 0; e < 4; ++e) {
                const float al = wa[0][2 * e] * bflo(a2[e]) + wa[1][2 * e] * bflo(a1[e]) + wa[2][2 * e] * bflo(a0[e]);
                const float ah = wa[0][2 * e + 1] * bfhi(a2[e]) + wa[1][2 * e + 1] * bfhi(a1[e]) + wa[2][2 * e + 1] * bfhi(a0[e]);
                const float bl = wb[0][2 * e] * bflo(b2[e]) + wb[1][2 * e] * bflo(b1[e]) + wb[2][2 * e] * bflo(b0[e]);
                const float bh = wb[0][2 * e + 1] * bfhi(b2[e]) + wb[1][2 * e + 1] * bfhi(b1[e]) + wb[2][2 * e + 1] * bfhi(b0[e]);
                o[e] = pkbf(al * fast_sigmoid(al) * bl, ah * fast_sigmoid(ah) * bh); }
            *(u32x4*)(H + (size_t)(t0 + tt) * FF + cg8) = o;
            a2 = a1; a1 = a0; b2 = b1; b1 = b0; }
    }
}

__global__ void __launch_bounds__(512, 2) fwd_mega(Args a) {
    extern __shared__ __attribute__((aligned(16))) unsigned char lds[];
    cg::grid_group grid = cg::this_grid();
    const int G = gridDim.x;
#define LAUNDER(x) do { int _t = __builtin_amdgcn_readfirstlane((int)(x)); asm volatile("" : "+s"(_t)); (x) = _t; } while (0)
#define LAUNDERP(T, p) do { unsigned long long _u = (unsigned long long)(p); unsigned _lo = __builtin_amdgcn_readfirstlane((unsigned)_u), _hi = __builtin_amdgcn_readfirstlane((unsigned)(_u >> 32)); \
    asm volatile("" : "+s"(_lo), "+s"(_hi)); (p) = (T)(((unsigned long long)_hi << 32) | _lo); } while (0)
#define PH_ENTER unsigned char* ws = a.ws; float* out = a.out; int l = lq; LAUNDERP(unsigned char*, ws); LAUNDERP(float*, out); LAUNDER(l); bf16_t* Wl = (bf16_t*)(ws + OFF_W) + (size_t)l * W_LAYER; (void)Wl; (void)out;
#define GSYNC grid.sync()
    if (PHM & 1) { prologue_phase(a, lds); } GSYNC;
#pragma clang loop unroll(disable)
    for (int lq = 0; lq < DEPTH; ++lq) {
        if (PHM & 2) { PH_ENTER pg8::Gemm g{(bf16_t*)(ws + OFF_XB), Wl + W_IN, M, NIN, D}; pg8::StaticOrder S; S.init(M, NIN, G, (int)blockIdx.x); EpiProj E{(bf16_t*)(ws + OFF_PA), (bf16_t*)(ws + OFF_GT)};
            pg8::gemm_phase<EpiProj, pg8::StaticOrder>((PG8_LAS unsigned char*)lds, g, S, E); } GSYNC;
        if (PHM & 4) { PH_ENTER mix_phase(a, ws, l, lds); } GSYNC;
        if (PHM & 8) { PH_ENTER pg8::Gemm g{(bf16_t*)(ws + OFF_XB), Wl + W_CAT, M, D, D}; pg8::StaticOrder S; S.init(M, D, G, (int)blockIdx.x); EpiMerge E{(bf16_t*)(ws + OFF_GT), (bf16_t*)(ws + OFF_MG)};
            pg8::gemm_phase<EpiMerge, pg8::StaticOrder>((PG8_LAS unsigned char*)lds, g, S, E); } GSYNC;
        if (PHM & 16) { PH_ENTER pg8::Gemm g{(bf16_t*)(ws + OFF_MG), Wl + W_O, M, D, D}; pg8::StaticOrder S; S.init(M, D, G, (int)blockIdx.x); EpiRes E{l == 0 ? a.in[0] : (const float*)out, out};
            pg8::gemm_phase<EpiRes, pg8::StaticOrder>((PG8_LAS unsigned char*)lds, g, S, E); } GSYNC;
        if (PHM & 32) { PH_ENTER ln_phase(out, out, (bf16_t*)(ws + OFF_XB), a.in[11] + l * D, a.in[12] + l * D); } GSYNC;
#pragma clang loop unroll(disable)
        for (int hq = 0; hq < 2; ++hq) {
            if (PHM & 64) { PH_ENTER int hf = hq; LAUNDER(hf); pg8::Gemm g{(bf16_t*)(ws + OFF_XB) + (size_t)hf * MH * D, Wl + W_UP, MH, NUP, D}; pg8::StaticOrder S; S.init(MH, NUP, G, (int)blockIdx.x); EpiBf E{(bf16_t*)(ws + OFF_UP), NUP};
                pg8::gemm_phase<EpiBf, pg8::StaticOrder>((PG8_LAS unsigned char*)lds, g, S, E); } GSYNC;
            if (PHM & 128) { PH_ENTER int hf = hq; LAUNDER(hf); act_phase(a, ws, l, hf); } GSYNC;
        }
        if (PHM & 256) { PH_ENTER pg8::Gemm g{(bf16_t*)(ws + OFF_H), Wl + W_DOWN, M, D, FF}; pg8::StaticOrder S; S.init(M, D, G, (int)blockIdx.x); EpiRes E{(const float*)out, out};
            pg8::gemm_phase<EpiRes, pg8::StaticOrder>((PG8_LAS unsigned char*)lds, g, S, E); } GSYNC;
        if (PHM & 512) { PH_ENTER ln_phase(out, out, (bf16_t*)(ws + OFF_XB), a.in[16] + l * D, a.in[17] + l * D); } if (lq + 1 < DEPTH) GSYNC;
    }
}
constexpr int N_PHASES = 1 + DEPTH * 11;

extern "C" void kernel_launch(void* const* d_in, const int* in_sizes, int n_in, void* d_out, int out_size, void* d_ws, size_t ws_size, hipStream_t stream) {
    static int grid = 0;
    if (grid == 0) {
        int dev = 0, cus = 0, per_cu = 0;
        (void)hipGetDevice(&dev); (void)hipDeviceGetAttribute(&cus, hipDeviceAttributeMultiprocessorCount, dev);
        if (hipFuncSetAttribute((const void*)fwd_mega, hipFuncAttributeMaxDynamicSharedMemorySize, LDS_BYTES) != hipSuccess) fprintf(stderr, "kernel_launch: hipFuncSetAttribute failed\n");
        if (hipOccupancyMaxActiveBlocksPerMultiprocessor(&per_cu, (const void*)fwd_mega, 512, LDS_BYTES) != hipSuccess || per_cu < 1) { fprintf(stderr, "kernel_launch: occupancy query says %d\n", per_cu); per_cu = 1; }
        (void)hipGetLastError();
        grid = cus * per_cu;
        if (n_in != 18 || out_size != M * D || ws_size < WS_NEED) fprintf(stderr, "kernel_launch: unexpected shapes n_in %d out %d ws %zu (need %zu)\n", n_in, out_size, ws_size, (size_t)WS_NEED);
        fprintf(stderr, "kernel_launch: grid %d (cus %d x %d), ws %zu\n", grid, cus, per_cu, ws_size);
    }
    Args a{};
    for (int i = 0; i < 18; ++i) a.in[i] = (const float*)d_in[i];
    a.out = (float*)d_out; a.ws = (unsigned char*)d_ws;
    for (int i = 0; i < 8; ++i) a.inv_freq[i] = std::pow(500000.0, -(double)(2 * i) / 16.0);
    void* args[] = {&a};
    hipError_t e = hipLaunchCooperativeKernel((void*)fwd_mega, dim3(grid), dim3(512), args, LDS_BYTES, stream);
    if (e != hipSuccess) fprintf(stderr, "kernel_launch: cooperative launch failed: %s (grid %d)\n", hipGetErrorString(e), grid);
}
```

```cpp
#include <hip/hip_runtime.h>
#include <hip/hip_cooperative_groups.h>
#include <cstdio>
#include <cmath>
namespace cg = cooperative_groups;
namespace pg8 {
#define PG8_LAS __attribute__((address_space(3)))
typedef unsigned short bf16_t;
typedef short bf16x8 __attribute__((ext_vector_type(8)));
typedef float f32x4 __attribute__((ext_vector_type(4)));
typedef unsigned u32x4 __attribute__((ext_vector_type(4)));
constexpr int BM = 256, BK = 64, HALF = 128, HTB = HALF * BK * 2  , STAGE_BYTES = 8 * HTB, NXCD = 8, WGM = 8;

__host__ __device__ __forceinline__ int lds_byte(int r, int c) { const int st = (r >> 4) * 2 + (c >> 5), rr = r & 15, cc = c & 31, ob = rr * 64 + cc * 2; return st * 1024 + (ob ^ (((ob >> 9) & 1) << 5)); }
__host__ __device__ __forceinline__ void stage_rc(int b, int& R, int& C) { const int st = b / 1024, sb = b % 1024, swz = sb ^ (((sb >> 9) & 1) << 5); R = (st >> 1) * 16 + swz / 64; C = (st & 1) * 32 + (swz % 64) / 2; }
__host__ __device__ __forceinline__ int perm32(int rho) { const int n = rho >> 4, i = rho & 15; return 8 * (i >> 2) + 4 * n + (i & 3); }

struct Unit { int pm, pn; };
struct Gemm { const bf16_t* A; const bf16_t* Bt; int M, N, K; };

struct StaticOrder {
    int nM, nN, nwg, G, c;
    __host__ __device__ void init(int M, int N, int G_, int c_) { nM = M / BM; nN = N / BM; nwg = nM * nN; G = G_; c = c_; }
    __host__ __device__ bool next(int i, Unit& u) const {
        const long L = (long)i * G + c; if (L >= nwg) return false;
        int wgid = (int)L; { const int q = nwg / NXCD, r = nwg % NXCD, xcd = wgid % NXCD, off = wgid / NXCD; wgid = (xcd < r ? xcd * (q + 1) : r * (q + 1) + (xcd - r) * q) + off; }
        const int nig = WGM * nN, gid = wgid / nig, fm = gid * WGM, gsz = (nM - fm) < WGM ? (nM - fm) : WGM;
        u.pm = fm + ((wgid % nig) % gsz); u.pn = (wgid % nig) / gsz; return true;
    }
    __device__ __forceinline__ void a_ready(const Unit&) const {}
    __device__ __forceinline__ void done(const Unit&) const {}
};
struct CountedOrder : StaticOrder {
    const unsigned* ready; unsigned need; unsigned* tmo;
    __device__ __forceinline__ void a_ready(const Unit& u) const {
        if (threadIdx.x < 64) {
            const unsigned long long t0 = __builtin_amdgcn_s_memrealtime(); unsigned polls = 0;
            while ((unsigned)__builtin_amdgcn_readfirstlane(__hip_atomic_load(ready + 64 * u.pm, __ATOMIC_RELAXED, __HIP_MEMORY_SCOPE_AGENT)) < need) {
                if ((++polls & 255u) == 0u && __builtin_amdgcn_readfirstlane(__hip_atomic_load(tmo, __ATOMIC_RELAXED, __HIP_MEMORY_SCOPE_AGENT)) != 0u) break;
                if (__builtin_amdgcn_s_memrealtime() - t0 > 2000000ull) {
                    if (threadIdx.x == 0) { unsigned expect = 0u; __hip_atomic_compare_exchange_strong(tmo + 1, &expect, 0x600u | (unsigned)(u.pm & 0xff), __ATOMIC_RELAXED, __ATOMIC_RELAXED, __HIP_MEMORY_SCOPE_AGENT); __hip_atomic_store(tmo, 1u, __ATOMIC_RELAXED, __HIP_MEMORY_SCOPE_AGENT); }
                    break; }
                __builtin_amdgcn_s_sleep(2); }
            __builtin_amdgcn_fence(__ATOMIC_ACQUIRE, "agent");
            asm volatile("s_waitcnt vmcnt(0)" ::: "memory");
        }
#if !defined(BROKEN_HOOK_NO_BARRIER)
        asm volatile("" ::: "memory"); __builtin_amdgcn_s_barrier(); asm volatile("" ::: "memory");
#endif
    }
};

__device__ __forceinline__ unsigned cvt_pk_bf16(float lo, float hi) { unsigned r; asm volatile("v_cvt_pk_bf16_f32 %0, %1, %2" : "=v"(r) : "v"(lo), "v"(hi)); return r; }
typedef float f32x2 __attribute__((ext_vector_type(2)));
__device__ __forceinline__ f32x2 gelu_pk(f32x2 v) {
    const f32x2 av = __builtin_elementwise_abs(v), d = av * 0.2316418882f + 1.0f;
    f32x2 t; t.x = __builtin_amdgcn_rcpf(d.x); t.y = __builtin_amdgcn_rcpf(d.y);
    f32x2 q = t * 0.5307027145f + (-0.7265760135f); q = q * t + 0.7107068705f; q = q * t + (-0.142248368f); q = q * t + 0.127414796f; q = q * t;
    const f32x2 s = (v * v) * (-0.72134752044f);
    f32x2 e; e.x = __builtin_amdgcn_exp2f(s.x); e.y = __builtin_amdgcn_exp2f(s.y);
    const f32x2 m = v * (q * e), r = v - m;
    f32x2 o; o.x = v.x < 0.f ? m.x : r.x; o.y = v.y < 0.f ? m.y : r.y; return o;
}

struct EpiF32 {
    static constexpr bool PERM = false, AFTER_DRAIN = false, MID = false;
    float* C; int ldc; const float* bias;
    __device__ __forceinline__ void operator()(const f32x4 (&acc)[2][2][4][2], const Unit& u, int wr, int wc, int fr, int fq) const {
        const int row0 = u.pm * BM + wr * 64 + fr, col0 = u.pn * BM + wc * 32 + 4 * fq;
        f32x4 bv[2][2];
#pragma unroll
        for (int bj = 0; bj < 2; ++bj)
#pragma unroll
            for (int n = 0; n < 2; ++n) bv[bj][n] = bias ? *(const f32x4*)(bias + col0 + bj * HALF + n * 16) : (f32x4){0.f, 0.f, 0.f, 0.f};
#pragma unroll
        for (int ai = 0; ai < 2; ++ai)
#pragma unroll
            for (int m = 0; m < 4; ++m) { float* rowp = C + (size_t)(row0 + ai * HALF + m * 16) * ldc + col0;
#pragma unroll
                for (int bj = 0; bj < 2; ++bj)
#pragma unroll
                    for (int n = 0; n < 2; ++n) *(f32x4*)(rowp + bj * HALF + n * 16) = acc[ai][bj][m][n] + bv[bj][n]; }
    }
};
template <int ACT  > struct EpiBf16 {
    static constexpr bool PERM = true, AFTER_DRAIN = false, MID = false;
    bf16_t* O; int ldc; const float* bias; int split_cols; size_t split_stride;
    __device__ __forceinline__ void operator()(const f32x4 (&acc)[2][2][4][2], const Unit& u, int wr, int wc, int fr, int fq) const {
        const int row0 = u.pm * BM + wr * 64 + fr; int colt = u.pn * BM; bf16_t* base = O;
        if (split_cols) { const int t = colt / split_cols; base += (size_t)t * split_stride; colt -= t * split_cols; }
        const int col0 = colt + wc * 32 + 8 * fq, bcol0 = u.pn * BM + wc * 32 + 8 * fq;
        f32x4 bv[2][2];
#pragma unroll
        for (int bj = 0; bj < 2; ++bj)
#pragma unroll
            for (int n = 0; n < 2; ++n) bv[bj][n] = bias ? *(const f32x4*)(bias + bcol0 + bj * HALF + 4 * n) : (f32x4){0.f, 0.f, 0.f, 0.f};
#pragma unroll
        for (int ai = 0; ai < 2; ++ai)
#pragma unroll
            for (int m = 0; m < 4; ++m) { bf16_t* rowp = base + (size_t)(row0 + ai * HALF + m * 16) * ldc + col0;
#pragma unroll
                for (int bj = 0; bj < 2; ++bj) { f32x4 v0 = acc[ai][bj][m][0] + bv[bj][0], v1 = acc[ai][bj][m][1] + bv[bj][1];
                    if (ACT == 1) { f32x2 a = gelu_pk((f32x2){v0[0], v0[1]}), b = gelu_pk((f32x2){v0[2], v0[3]}), c = gelu_pk((f32x2){v1[0], v1[1]}), d = gelu_pk((f32x2){v1[2], v1[3]});
                        v0 = (f32x4){a.x, a.y, b.x, b.y}; v1 = (f32x4){c.x, c.y, d.x, d.y}; }
                    if (ACT == 2) {
#pragma unroll
                        for (int j = 0; j < 4; ++j) { v0[j] = 0.5f * v0[j] * (1.0f + erff(v0[j] * 0.70710678f)); v1[j] = 0.5f * v1[j] * (1.0f + erff(v1[j] * 0.70710678f)); } }
                    u32x4 w; w.x = cvt_pk_bf16(v0[0], v0[1]); w.y = cvt_pk_bf16(v0[2], v0[3]); w.z = cvt_pk_bf16(v1[0], v1[1]); w.w = cvt_pk_bf16(v1[2], v1[3]);
                    *(u32x4*)(rowp + bj * HALF) = w; } }
    }
};

struct PanelStats {
    unsigned* xbuf;
    unsigned* cnt;
    unsigned* tmo;
    int ntn; float eps;
    unsigned code;
    __device__ __forceinline__ bool run(const f32x4 (&v)[2][2][4][2], const Unit& u, int wr, int wc, int fr, int fq, PG8_LAS unsigned char* lds, int wid, int lane) const {
        typedef float f32x2v __attribute__((ext_vector_type(2)));
        PG8_LAS f32x2v* P = (PG8_LAS f32x2v*)lds;
        PG8_LAS f32x2v* S = (PG8_LAS f32x2v*)(lds + 8192);
        PG8_LAS unsigned* flag = (PG8_LAS unsigned*)(lds + 8192 + 2048);
#pragma unroll
        for (int ai = 0; ai < 2; ++ai)
#pragma unroll
            for (int m = 0; m < 4; ++m) {
                float s = 0.f;
#pragma unroll
                for (int bj = 0; bj < 2; ++bj)
#pragma unroll
                    for (int n = 0; n < 2; ++n) { const f32x4 x = v[ai][bj][m][n]; s += (x[0] + x[1]) + (x[2] + x[3]); }
                s += __shfl_xor(s, 16); s += __shfl_xor(s, 32);
                const float mw = s * (1.0f / 64.0f); float q = 0.f;
#pragma unroll
                for (int bj = 0; bj < 2; ++bj)
#pragma unroll
                    for (int n = 0; n < 2; ++n) { const f32x4 d = v[ai][bj][m][n] - mw; q += (d[0] * d[0] + d[1] * d[1]) + (d[2] * d[2] + d[3] * d[3]); }
                q += __shfl_xor(q, 16); q += __shfl_xor(q, 32);
                if (fq == 0) P[(ai * HALF + wr * 64 + m * 16 + fr) * 4 + wc] = (f32x2v){mw, q};
            }
        asm volatile("s_waitcnt lgkmcnt(0)" ::: "memory"); __builtin_amdgcn_s_barrier(); asm volatile("" ::: "memory");
#if defined(BROKEN_NO_WAIT)
        if (blockIdx.x >= 64) { const long long t0 = clock64(); while (clock64() - t0 < 60000) __builtin_amdgcn_s_sleep(8); }
#endif
        const int row = wid * 32 + (lane & 31);
        if (lane < 32) {
            const f32x2v a = P[row * 4 + 0], b = P[row * 4 + 1], c = P[row * 4 + 2], d = P[row * 4 + 3];
            const float mt = (a.x + b.x + c.x + d.x) * 0.25f;
            const float da = a.x - mt, db = b.x - mt, dc = c.x - mt, dd = d.x - mt;
            const float m2 = (a.y + b.y) + (c.y + d.y) + 64.0f * ((da * da + db * db) + (dc * dc + dd * dd));
            unsigned long long* slot = (unsigned long long*)xbuf + ((size_t)(u.pm * BM + row) * 4 + u.pn);
            __hip_atomic_store(slot, ((unsigned long long)__float_as_uint(m2) << 32) | __float_as_uint(mt), __ATOMIC_RELAXED, __HIP_MEMORY_SCOPE_AGENT);
        }
        asm volatile("s_waitcnt vmcnt(0)" ::: "memory");
        if (lane == 0) __hip_atomic_fetch_add(cnt + 64 * u.pm, 1u, __ATOMIC_RELAXED, __HIP_MEMORY_SCOPE_AGENT);
        if (wid == 0) {
            bool dead = false; const unsigned long long t0 = __builtin_amdgcn_s_memrealtime(); const unsigned want = 8u * (unsigned)ntn;
            for (;;) {
#if defined(BROKEN_NO_WAIT)
                break;
#endif
                if ((unsigned)__builtin_amdgcn_readfirstlane(__hip_atomic_load(cnt + 64 * u.pm, __ATOMIC_RELAXED, __HIP_MEMORY_SCOPE_AGENT)) >= want) break;
                if (__builtin_amdgcn_s_memrealtime() - t0 > 2000000ull) {
                    if (lane == 0) { unsigned expect = 0u; __hip_atomic_compare_exchange_strong(tmo + 1, &expect, code | (unsigned)(u.pm & 0xff), __ATOMIC_RELAXED, __ATOMIC_RELAXED, __HIP_MEMORY_SCOPE_AGENT);
                                     __hip_atomic_store(tmo, 1u, __ATOMIC_RELAXED, __HIP_MEMORY_SCOPE_AGENT); }
                    dead = true; break; }
                __builtin_amdgcn_s_sleep(2);
            }
            __builtin_amdgcn_fence(__ATOMIC_ACQUIRE, "agent");
            if (lane == 0) flag[0] = dead ? 1u : 0u;
        }
        asm volatile("s_waitcnt vmcnt(0) lgkmcnt(0)" ::: "memory"); __builtin_amdgcn_s_barrier(); asm volatile("" ::: "memory");
        const bool bad = flag[0] != 0u;
        if (lane < 32) {
            const unsigned long long* slot = (const unsigned long long*)xbuf + (size_t)(u.pm * BM + row) * 4; float mt[4], m2[4]; float ms = 0.f;
#pragma unroll
            for (int t = 0; t < 4; ++t) { if (t < ntn) { const unsigned long long w = __hip_atomic_load(slot + t, __ATOMIC_RELAXED, __HIP_MEMORY_SCOPE_AGENT); mt[t] = __uint_as_float((unsigned)w); m2[t] = __uint_as_float((unsigned)(w >> 32)); } else { mt[t] = 0.f; m2[t] = 0.f; } ms += mt[t]; }
            const float mean = ms / (float)ntn; float q = 0.f;
#pragma unroll
            for (int t = 0; t < 4; ++t) if (t < ntn) { const float dm = mt[t] - mean; q += m2[t] + 256.0f * dm * dm; }
            S[row] = (f32x2v){mean, 1.0f / sqrtf(q / (256.0f * (float)ntn) + eps)};
        }
        asm volatile("s_waitcnt lgkmcnt(0)" ::: "memory"); __builtin_amdgcn_s_barrier(); asm volatile("" ::: "memory");
        return bad;
    }
};
struct EpiLnRes {
    static constexpr bool PERM = false, AFTER_DRAIN = true, MID = false;
    const float* base; float* out; int ldc; const float* bias; PanelStats st; unsigned poison;
    __device__ __forceinline__ void refuse(size_t i0, size_t stride, int M, int N) const { const float q = __builtin_nanf(""); for (size_t i = i0; i < (size_t)M * N; i += stride) out[(i / N) * ldc + i % N] = q;
        if (i0 == 0) { unsigned expect = 0u; __hip_atomic_compare_exchange_strong(st.tmo + 1, &expect, 0x7f0u, __ATOMIC_RELAXED, __ATOMIC_RELAXED, __HIP_MEMORY_SCOPE_AGENT); __hip_atomic_store(st.tmo, 1u, __ATOMIC_RELAXED, __HIP_MEMORY_SCOPE_AGENT); } }
    __device__ __forceinline__ void fused(f32x4 (&acc)[2][2][4][2], const Unit& u, int wr, int wc, int fr, int fq, PG8_LAS unsigned char* lds, int wid, int lane) const {
        typedef float f32x2v __attribute__((ext_vector_type(2)));
        const PG8_LAS f32x2v* S = (const PG8_LAS f32x2v*)(lds + 8192);
        const int col0 = u.pn * BM + wc * 32 + 4 * fq;
#pragma unroll
        for (int bj = 0; bj < 2; ++bj)
#pragma unroll
            for (int n = 0; n < 2; ++n) { const f32x4 bv = bias ? *(const f32x4*)(bias + col0 + bj * HALF + n * 16) : (f32x4){0.f, 0.f, 0.f, 0.f};
#pragma unroll
                for (int ai = 0; ai < 2; ++ai)
#pragma unroll
                    for (int m = 0; m < 4; ++m) acc[ai][bj][m][n] += bv; }
        const bool bad = st.run(acc, u, wr, wc, fr, fq, lds, wid, lane) || poison != 0u;
        const float qnan = __builtin_nanf("");
#pragma unroll
        for (int ai = 0; ai < 2; ++ai)
#pragma unroll
            for (int m = 0; m < 4; ++m) { const int r = ai * HALF + wr * 64 + m * 16 + fr; const f32x2v sr = S[r]; const size_t off = (size_t)(u.pm * BM + r) * ldc + col0;
#pragma unroll
                for (int bj = 0; bj < 2; ++bj)
#pragma unroll
                    for (int n = 0; n < 2; ++n) { const f32x4 bs = *(const f32x4*)(base + off + bj * HALF + n * 16); f32x4 o = bs + (acc[ai][bj][m][n] - sr.x) * sr.y;
                        if (bad) o = (f32x4){qnan, qnan, qnan, qnan}; *(f32x4*)(out + off + bj * HALF + n * 16) = o; }
                asm volatile("" ::: "memory"); }
    }
};
struct EpiLnResLn {
    static constexpr bool PERM = false, AFTER_DRAIN = true, MID = false;
    const float* base; float* out; bf16_t* xn; int ldc; const float* bias; PanelStats st1, st2; unsigned poison;
    __device__ __forceinline__ void refuse(size_t i0, size_t stride, int M, int N) const { const float q = __builtin_nanf(""); for (size_t i = i0; i < (size_t)M * N; i += stride) { const size_t o = (i / N) * ldc + i % N; out[o] = q; xn[o] = (bf16_t)0x7fc0u; }
        if (i0 == 0) { unsigned expect = 0u; __hip_atomic_compare_exchange_strong(st1.tmo + 1, &expect, 0x7f0u, __ATOMIC_RELAXED, __ATOMIC_RELAXED, __HIP_MEMORY_SCOPE_AGENT); __hip_atomic_store(st1.tmo, 1u, __ATOMIC_RELAXED, __HIP_MEMORY_SCOPE_AGENT); } }
    __device__ __forceinline__ void fused(f32x4 (&acc)[2][2][4][2], const Unit& u, int wr, int wc, int fr, int fq, PG8_LAS unsigned char* lds, int wid, int lane) const {
        typedef float f32x2v __attribute__((ext_vector_type(2))); typedef unsigned u32x2v __attribute__((ext_vector_type(2)));
        const PG8_LAS f32x2v* S = (const PG8_LAS f32x2v*)(lds + 8192);
        const int col0 = u.pn * BM + wc * 32 + 4 * fq;
#pragma unroll
        for (int bj = 0; bj < 2; ++bj)
#pragma unroll
            for (int n = 0; n < 2; ++n) { const f32x4 bv = bias ? *(const f32x4*)(bias + col0 + bj * HALF + n * 16) : (f32x4){0.f, 0.f, 0.f, 0.f};
#pragma unroll
                for (int ai = 0; ai < 2; ++ai)
#pragma unroll
                    for (int m = 0; m < 4; ++m) acc[ai][bj][m][n] += bv; }
        bool bad = st1.run(acc, u, wr, wc, fr, fq, lds, wid, lane) || poison != 0u;
        const float qnan = __builtin_nanf("");
#pragma unroll
        for (int ai = 0; ai < 2; ++ai)
#pragma unroll
            for (int m = 0; m < 4; ++m) { const int r = ai * HALF + wr * 64 + m * 16 + fr; const f32x2v sr = S[r]; const size_t off = (size_t)(u.pm * BM + r) * ldc + col0;
#pragma unroll
                for (int bj = 0; bj < 2; ++bj)
#pragma unroll
                    for (int n = 0; n < 2; ++n) { const f32x4 bs = *(const f32x4*)(base + off + bj * HALF + n * 16); acc[ai][bj][m][n] = bs + (acc[ai][bj][m][n] - sr.x) * sr.y; }
                asm volatile("" : "+v"(acc[ai][0][m][0]), "+v"(acc[ai][0][m][1]), "+v"(acc[ai][1][m][0]), "+v"(acc[ai][1][m][1]));
                if (m & 1) asm volatile("" ::: "memory"); }
        const bool bad1 = bad;
        bad = st2.run(acc, u, wr, wc, fr, fq, lds, wid, lane) || bad;
#pragma unroll
        for (int ai = 0; ai < 2; ++ai)
#pragma unroll
            for (int m = 0; m < 4; ++m) { const int r = ai * HALF + wr * 64 + m * 16 + fr; const f32x2v sr = S[r]; const size_t off = (size_t)(u.pm * BM + r) * ldc + col0;
#pragma unroll
                for (int bj = 0; bj < 2; ++bj)
#pragma unroll
                    for (int n = 0; n < 2; ++n) { const f32x4 x1 = acc[ai][bj][m][n]; *(f32x4*)(out + off + bj * HALF + n * 16) = bad1 ? (f32x4){qnan, qnan, qnan, qnan} : x1;
                        const f32x4 o = (x1 - sr.x) * sr.y; u32x2v w; w.x = cvt_pk_bf16(o[0], o[1]); w.y = cvt_pk_bf16(o[2], o[3]);
                        if (bad) { w.x = 0x7fc07fc0u; w.y = 0x7fc07fc0u; } *(u32x2v*)(xn + off + bj * HALF + n * 16) = w; }
                asm volatile("" ::: "memory"); }
    }
};

template <class Epi, class Sched, bool STAMP = false>
__device__ __forceinline__ void gemm_phase(PG8_LAS unsigned char* lds, const Gemm g, const Sched& S, const Epi& E, unsigned long long* stamps = nullptr) {
    int tid_ = threadIdx.x; asm volatile("" : "+v"(tid_));
    const int tid = tid_, wid = __builtin_amdgcn_readfirstlane(tid >> 6), lane = tid & 63, wr = wid >> 2, wc = wid & 3, fr = lane & 15, fq = lane >> 4;
    const int K = g.K, nt = K / BK;
    int ts_lo = 0, ts_hi = 0, nts = 0; const unsigned long long rt_entry = STAMP ? (unsigned long long)wall_clock64() : 0ull;
#define PG8_STAMP() do { if (STAMP && wid == 0 && nts < 64) { const unsigned long long _c = (unsigned long long)clock64(); \
        ts_lo = (lane == nts) ? (int)(unsigned)_c : ts_lo; ts_hi = (lane == nts) ? (int)(unsigned)(_c >> 32) : ts_hi; ++nts; } } while (0)
    PG8_STAMP();
    unsigned voffA[2], voffB[2];
#pragma unroll
    for (int i = 0; i < 2; ++i) { int R, C; stage_rc(tid * 16 + i * 8192, R, C); const int Rb = Epi::PERM ? ((R & ~31) + perm32(R & 31)) : R;
        voffA[i] = (unsigned)(R * K + C) * 2u; voffB[i] = (unsigned)(Rb * K + C) * 2u; }
    const size_t kstep = (size_t)(BK * 2);
    const size_t hstep = (size_t)HALF * K * 2;
    const size_t tstep = 2 * hstep;
    const unsigned ldsw = (unsigned)wid * 1024u;
    const int aoff = lds_byte(wr * 64 + fr, fq * 8), boff = lds_byte(wc * 32 + fr, fq * 8);
#define PG8_SA(b, h) (((b) * 2 + (h)) * HTB)
#define PG8_SB(b, h) ((4 + (b) * 2 + (h)) * HTB)
#define PG8_STAGE(bufoff, gbase, voff) do { _Pragma("unroll") for (int _i = 0; _i < 2; ++_i) \
        __builtin_amdgcn_global_load_lds((const unsigned*)((const char*)(gbase) + (voff)[_i]), (PG8_LAS unsigned*)(lds + (bufoff) + ldsw + _i * 8192), 16, 0, 0); } while (0)
#define PG8_LDA(dst, b, h) do { _Pragma("unroll") for (int m = 0; m < 4; ++m) _Pragma("unroll") for (int k = 0; k < 2; ++k) dst[m][k] = *(const PG8_LAS bf16x8*)(lds + PG8_SA(b, h) + aoff + m * 2048 + k * 1024); } while (0)
#define PG8_LDB(dst, b, h) do { _Pragma("unroll") for (int n = 0; n < 2; ++n) _Pragma("unroll") for (int k = 0; k < 2; ++k) dst[n][k] = *(const PG8_LAS bf16x8*)(lds + PG8_SB(b, h) + boff + n * 2048 + k * 1024); } while (0)
#define PG8_MMA(ai, bj, At, Bt) do { __builtin_amdgcn_s_setprio(1); _Pragma("unroll") for (int m = 0; m < 4; ++m) _Pragma("unroll") for (int n = 0; n < 2; ++n) _Pragma("unroll") for (int k = 0; k < 2; ++k) \
        acc[ai][bj][m][n] = __builtin_amdgcn_mfma_f32_16x16x32_bf16(Bt[n][k], At[m][k], acc[ai][bj][m][n], 0, 0, 0); __builtin_amdgcn_s_setprio(0); } while (0)
#define PG8_WAIT_V(n) asm volatile("s_waitcnt vmcnt(" #n ")" ::: "memory")
#define PG8_WAIT_L(n) asm volatile("s_waitcnt lgkmcnt(" #n ")" ::: "memory")
#define PG8_BAR __builtin_amdgcn_s_barrier()
#define PG8_SCHED __builtin_amdgcn_sched_barrier(0)
    Unit cur, nxt; int ui = 0;
    if (!S.next(0, cur)) return;
    f32x4 acc[2][2][4][2];
#pragma unroll
    for (int a = 0; a < 2; ++a)
#pragma unroll
        for (int b = 0; b < 2; ++b)
#pragma unroll
            for (int m = 0; m < 4; ++m)
#pragma unroll
                for (int n = 0; n < 2; ++n) acc[a][b][m][n] = (f32x4){0.f, 0.f, 0.f, 0.f};
    bf16x8 At[4][2], B0[2][2], B1[2][2];
    const char* cA = (const char*)g.A + (size_t)cur.pm * tstep; const char* cB = (const char*)g.Bt + (size_t)cur.pn * tstep;
    S.a_ready(cur);
    PG8_STAGE(PG8_SB(0, 0), cB, voffB); PG8_STAGE(PG8_SA(0, 0), cA, voffA); PG8_STAGE(PG8_SB(0, 1), cB + hstep, voffB); PG8_STAGE(PG8_SA(0, 1), cA + hstep, voffA);
    if (wr == 1) PG8_BAR;
    PG8_WAIT_V(4); PG8_BAR;
    PG8_STAGE(PG8_SB(1, 0), cB + kstep, voffB); PG8_STAGE(PG8_SA(1, 0), cA + kstep, voffA); PG8_STAGE(PG8_SB(1, 1), cB + hstep + kstep, voffB);
    PG8_WAIT_V(6); PG8_BAR;
    PG8_STAMP();
    for (;;) {
        const bool has_next = S.next(ui + 1, nxt);
        const char* nA = has_next ? (const char*)g.A + (size_t)nxt.pm * tstep : cA; const char* nB = has_next ? (const char*)g.Bt + (size_t)nxt.pn * tstep : cB;
        for (int t = 0; t < nt; t += 2) {
            const bool last = (t == nt - 2);
            const char* a1 = cA + (size_t)(t + 1) * kstep;
            const char* a2 = last ? nA : cA + (size_t)(t + 2) * kstep; const char* b2 = last ? nB : cB + (size_t)(t + 2) * kstep;
            const char* a3 = a2 + kstep; const char* b3 = b2 + kstep;
            if (last && has_next) S.a_ready(nxt);
            if constexpr (Epi::MID) { if (t == 4 || t == 12) E.mid(acc, cur, t == 12 ? 1 : 0, wr, wc, fr, fq); }
            PG8_LDB(B0, 0, 0); PG8_SCHED; PG8_LDA(At, 0, 0); PG8_STAGE(PG8_SA(1, 1), a1 + hstep, voffA);
            PG8_WAIT_L(8); PG8_BAR; PG8_WAIT_L(0); PG8_MMA(0, 0, At, B0); PG8_BAR; PG8_SCHED;
            PG8_LDB(B1, 0, 1); PG8_STAGE(PG8_SB(0, 0), b2, voffB);
            PG8_BAR; PG8_WAIT_L(0); PG8_MMA(0, 1, At, B1); PG8_BAR;
            PG8_LDA(At, 0, 1); PG8_STAGE(PG8_SA(0, 0), a2, voffA);
            PG8_BAR; PG8_WAIT_L(0); PG8_MMA(1, 0, At, B0); PG8_BAR; PG8_SCHED;
            PG8_STAGE(PG8_SB(0, 1), b2 + hstep, voffB);
            PG8_WAIT_V(6); PG8_BAR; PG8_MMA(1, 1, At, B1); PG8_BAR;
            PG8_LDB(B0, 1, 0); PG8_SCHED; PG8_LDA(At, 1, 0); PG8_STAGE(PG8_SA(0, 1), a2 + hstep, voffA);
            PG8_WAIT_L(8); PG8_BAR; PG8_WAIT_L(0); PG8_MMA(0, 0, At, B0); PG8_BAR; PG8_SCHED;
            PG8_LDB(B1, 1, 1); PG8_STAGE(PG8_SB(1, 0), b3, voffB);
            PG8_BAR; PG8_WAIT_L(0); PG8_MMA(0, 1, At, B1); PG8_BAR;
            PG8_LDA(At, 1, 1); PG8_STAGE(PG8_SA(1, 0), a3, voffA);
            PG8_BAR; PG8_WAIT_L(0); PG8_MMA(1, 0, At, B0); PG8_BAR; PG8_SCHED;
            PG8_STAGE(PG8_SB(1, 1), b3 + hstep, voffB);
            PG8_WAIT_V(6); PG8_BAR; PG8_MMA(1, 1, At, B1); PG8_BAR;
        }
        PG8_STAMP();
        if constexpr (!Epi::AFTER_DRAIN) { E(acc, cur, wr, wc, fr, fq); S.done(cur); }
        PG8_STAMP();
        if (!has_next) break;
#pragma unroll
        for (int a = 0; a < 2; ++a)
#pragma unroll
            for (int b = 0; b < 2; ++b)
#pragma unroll
                for (int m = 0; m < 4; ++m)
#pragma unroll
                    for (int n = 0; n < 2; ++n) acc[a][b][m][n] = (f32x4){0.f, 0.f, 0.f, 0.f};
        cur = nxt; cA = nA; cB = nB; ++ui;
    }
    PG8_WAIT_V(0);
    if (wr == 0) PG8_BAR;
    PG8_BAR;
    if constexpr (Epi::AFTER_DRAIN) { E.fused(acc, cur, wr, wc, fr, fq, lds, wid, lane); S.done(cur); }
    PG8_STAMP();
    if (STAMP && wid == 0) { stamps[lane] = lane < nts ? (((unsigned long long)(unsigned)ts_hi << 32) | (unsigned)ts_lo) : 0ull;
        if (lane == 62) stamps[62] = rt_entry; if (lane == 63) stamps[63] = (unsigned long long)wall_clock64(); }
#undef PG8_STAMP
#undef PG8_SA
#undef PG8_SB
#undef PG8_STAGE
#undef PG8_LDA
#undef PG8_LDB
#undef PG8_MMA
#undef PG8_WAIT_V
#undef PG8_WAIT_L
#undef PG8_BAR
#undef PG8_SCHED
}
}

typedef unsigned short bf16_t;
typedef unsigned u32x4 __attribute__((ext_vector_type(4)));
typedef unsigned u32x2 __attribute__((ext_vector_type(2)));
typedef float f32x4 __attribute__((ext_vector_type(4)));
typedef short bf16x8 __attribute__((ext_vector_type(8)));
#define LAS __attribute__((address_space(3)))

constexpr int M = 65536, D = 1024, SEQ = 8192, NIN = 4864, NPA = 1792, NGT = 3072, FF = 2816, NUP = 5632, DEPTH = 4, MH = 32768;
constexpr size_t MiB = (size_t)1 << 20;
constexpr size_t OFF_ROPE = 0, OFF_CTL = 5 * MiB, OFF_W = 8 * MiB, OFF_XB = 130 * MiB, OFF_R = 258 * MiB;
constexpr size_t W_IN = 0, W_CAT = W_IN + (size_t)4864 * 1024, W_O = W_CAT + (size_t)1024 * 1024, W_UP = W_O + (size_t)1024 * 1024,
                 W_DOWN = W_UP + (size_t)5632 * 1024, W_POOL = W_DOWN + (size_t)1024 * 2816, W_LAYER = W_POOL + 16384;
constexpr size_t OFF_PA = OFF_R, OFF_GT = OFF_R + 224 * MiB, OFF_MG = OFF_R, OFF_UP = OFF_R, OFF_H = OFF_R + 352 * MiB;
constexpr size_t WS_NEED = OFF_R + 704 * MiB;
constexpr int LDS_BYTES = 144 * 1024;
#ifndef PHM
#define PHM 1023
#endif
#ifndef PHX
#define PHX 0
#endif
#define REP(b) for (int _rep = 0; _rep < (((PHX) & (b)) ? 2 : 1); ++_rep)
constexpr float ALPHA = 1.681792830507429f;
constexpr float LN_EPS = 1e-5f;

__device__ __forceinline__ float bflo(unsigned w) { return __uint_as_float(w << 16); }
__device__ __forceinline__ float bfhi(unsigned w) { return __uint_as_float(w & 0xffff0000u); }
__device__ __forceinline__ unsigned pkbf(float lo, float hi) { return pg8::cvt_pk_bf16(lo, hi); }
__device__ __forceinline__ float fast_sigmoid(float x) { return __builtin_amdgcn_rcpf(1.0f + __expf(-x)); }

struct EpiProj {
    static constexpr bool PERM = true, AFTER_DRAIN = false, MID = false;
    bf16_t* pa; bf16_t* gt;
    __device__ __forceinline__ void operator()(const f32x4 (&acc)[2][2][4][2], const pg8::Unit& u, int wr, int wc, int fr, int fq) const {
        const int row0 = u.pm * 256 + wr * 64 + fr; const bool sg = u.pn >= 7;
        bf16_t* base = sg ? gt + (u.pn - 7) * 256 : pa + u.pn * 256; const int ldc = sg ? NGT : NPA;
        const int col0 = wc * 32 + 8 * fq;
#pragma unroll
        for (int ai = 0; ai < 2; ++ai)
#pragma unroll
            for (int m = 0; m < 4; ++m) { bf16_t* rowp = base + (size_t)(row0 + ai * 128 + m * 16) * ldc + col0;
#pragma unroll
                for (int bj = 0; bj < 2; ++bj) { f32x4 v0 = acc[ai][bj][m][0], v1 = acc[ai][bj][m][1];
                    if (sg) {
#pragma unroll
                        for (int j = 0; j < 4; ++j) { v0[j] = fast_sigmoid(v0[j]); v1[j] = fast_sigmoid(v1[j]); } }
                    u32x4 w; w.x = pkbf(v0[0], v0[1]); w.y = pkbf(v0[2], v0[3]); w.z = pkbf(v1[0], v1[1]); w.w = pkbf(v1[2], v1[3]);
                    *(u32x4*)(rowp + bj * 128) = w; } }
    }
};
struct EpiBf {
    static constexpr bool PERM = true, AFTER_DRAIN = false, MID = false;
    bf16_t* O; int ldc;
    __device__ __forceinline__ void operator()(const f32x4 (&acc)[2][2][4][2], const pg8::Unit& u, int wr, int wc, int fr, int fq) const {
        const int row0 = u.pm * 256 + wr * 64 + fr; const int col0 = u.pn * 256 + wc * 32 + 8 * fq;
#pragma unroll
        for (int ai = 0; ai < 2; ++ai)
#pragma unroll
            for (int m = 0; m < 4; ++m) { bf16_t* rowp = O + (size_t)(row0 + ai * 128 + m * 16) * ldc + col0;
#pragma unroll
                for (int bj = 0; bj < 2; ++bj) { const f32x4 v0 = acc[ai][bj][m][0], v1 = acc[ai][bj][m][1];
                    u32x4 w; w.x = pkbf(v0[0], v0[1]); w.y = pkbf(v0[2], v0[3]); w.z = pkbf(v1[0], v1[1]); w.w = pkbf(v1[2], v1[3]);
                    *(u32x4*)(rowp + bj * 128) = w; } }
    }
};
struct EpiMerge {
    static constexpr bool PERM = true, AFTER_DRAIN = false, MID = true;
    const bf16_t* gt; bf16_t* O;
    __device__ __forceinline__ void mid(f32x4 (&acc)[2][2][4][2], const pg8::Unit& u, int which, int wr, int wc, int fr, int fq) const {
        const char* gb = (const char*)gt;
        const unsigned off = ((unsigned)(u.pm * 256 + wr * 64 + fr) * (unsigned)NGT + (unsigned)(which * 1024 + u.pn * 256 + wc * 32 + 8 * fq)) * 2u;
#pragma unroll
        for (int ai = 0; ai < 2; ++ai)
#pragma unroll
            for (int m = 0; m < 4; ++m) { const unsigned o = off + (unsigned)((ai * 128 + m * 16) * NGT * 2);
#pragma unroll
                for (int bj = 0; bj < 2; ++bj) { const u32x4 a = *(const u32x4*)(gb + o + bj * 256), b = *(const u32x4*)(gb + o + 2048 + bj * 256);
#pragma unroll
                    for (int n = 0; n < 2; ++n) { const unsigned a0 = n ? a.z : a.x, a1 = n ? a.w : a.y, b0 = n ? b.z : b.x, b1 = n ? b.w : b.y;
                        f32x4 r; r[0] = bflo(a0) * __builtin_amdgcn_rcpf(fmaxf(bflo(b0), 1e-30f)); r[1] = bfhi(a0) * __builtin_amdgcn_rcpf(fmaxf(bfhi(b0), 1e-30f));
                        r[2] = bflo(a1) * __builtin_amdgcn_rcpf(fmaxf(bflo(b1), 1e-30f)); r[3] = bfhi(a1) * __builtin_amdgcn_rcpf(fmaxf(bfhi(b1), 1e-30f));
                        acc[ai][bj][m][n] *= r; } }
                asm volatile("" ::: "memory"); }
    }
    __device__ __forceinline__ void operator()(const f32x4 (&acc)[2][2][4][2], const pg8::Unit& u, int wr, int wc, int fr, int fq) const {
        const int row0 = u.pm * 256 + wr * 64 + fr; const int col0 = u.pn * 256 + wc * 32 + 8 * fq;
        const bf16_t* g2 = gt + 2048;
#pragma unroll
        for (int ai = 0; ai < 2; ++ai)
#pragma unroll
            for (int m = 0; m < 4; ++m) { const size_t r = (size_t)(row0 + ai * 128 + m * 16);
#pragma unroll
                for (int bj = 0; bj < 2; ++bj) { const u32x4 a = *(const u32x4*)(g2 + r * NGT + col0 + bj * 128);
                    const f32x4 v0 = acc[ai][bj][m][0], v1 = acc[ai][bj][m][1];
                    u32x4 w; w.x = pkbf(v0[0] * bflo(a.x), v0[1] * bfhi(a.x)); w.y = pkbf(v0[2] * bflo(a.y), v0[3] * bfhi(a.y));
                    w.z = pkbf(v1[0] * bflo(a.z), v1[1] * bfhi(a.z)); w.w = pkbf(v1[2] * bflo(a.w), v1[3] * bfhi(a.w));
                    *(u32x4*)(O + r * D + col0 + bj * 128) = w; } }
    }
};
struct EpiRes {
    static constexpr bool PERM = false, AFTER_DRAIN = false, MID = false;
    const float* res; float* out;
    __device__ __forceinline__ void operator()(const f32x4 (&acc)[2][2][4][2], const pg8::Unit& u, int wr, int wc, int fr, int fq) const {
        const int row0 = u.pm * 256 + wr * 64 + fr, col0 = u.pn * 256 + wc * 32 + 4 * fq;
#pragma unroll
        for (int ai = 0; ai < 2; ++ai)
#pragma unroll
            for (int m = 0; m < 4; ++m) { const size_t off = (size_t)(row0 + ai * 128 + m * 16) * D + col0;
#pragma unroll
                for (int bj = 0; bj < 2; ++bj)
#pragma unroll
                    for (int n = 0; n < 2; ++n) { const f32x4 bs = *(const f32x4*)(res + off + bj * 128 + n * 16);
                        *(f32x4*)(out + off + bj * 128 + n * 16) = bs * ALPHA + acc[ai][bj][m][n]; }
                asm volatile("" ::: "memory"); }
    }
};

__device__ __forceinline__ float wave_sum(float v) {
#pragma unroll
    for (int o = 1; o < 64; o <<= 1) v += __shfl_xor(v, o);
    return v;
}
__device__ __forceinline__ void transpose_item(const float* W, int N, bf16_t* WT, int pitch, int koff, LAS float* scr, int item, int lane) {
    const int nblk = N / 32, kb = item / nblk, nb = item % nblk, k0 = 64 * kb, n0 = 32 * nb;
#pragma unroll 8
    for (int i = 0; i < 32; ++i) { const int kk = 2 * i + (lane >> 5); scr[kk * 33 + (lane & 31)] = W[(size_t)(k0 + kk) * N + n0 + (lane & 31)]; }
    asm volatile("s_waitcnt lgkmcnt(0)" ::: "memory");
    const int c = lane & 7;
#pragma unroll
    for (int j = 0; j < 4; ++j) { const int n = (lane >> 3) + 8 * j; const LAS float* s = scr + (8 * c) * 33 + n;
        u32x4 o; o.x = pkbf(s[0 * 33], s[1 * 33]); o.y = pkbf(s[2 * 33], s[3 * 33]); o.z = pkbf(s[4 * 33], s[5 * 33]); o.w = pkbf(s[6 * 33], s[7 * 33]);
        *(u32x4*)(WT + (size_t)(n0 + n) * pitch + koff + k0 + 8 * c) = o; }
    asm volatile("s_waitcnt lgkmcnt(0)" ::: "memory");
}

struct Args { const float* in[18]; float* out; unsigned char* ws; double inv_freq[8]; };

__device__ __forceinline__ void prologue_phase(const Args& a, unsigned char* lds_g) {
    int tid = threadIdx.x; asm volatile("" : "+v"(tid)); const int lane = tid & 63, wave = __builtin_amdgcn_readfirstlane(tid >> 6);
    LAS float* scr = (LAS float*)((LAS unsigned char*)lds_g + wave * 16384);
    const int gw = blockIdx.x * 8 + wave, NGW = gridDim.x * 8;
    constexpr int I_IN = 16 * 152, I_A = 4 * 32, I_B = 8 * 32, I_C = 4 * 32, I_O = 16 * 32, I_UP = 16 * 176, I_DN = 44 * 32, I_PL = 8;
    constexpr int I_LAYER = I_IN + I_A + I_B + I_C + I_O + I_UP + I_DN + I_PL;
    bf16_t* Wb = (bf16_t*)(a.ws + OFF_W);
    for (int it = gw; it < DEPTH * I_LAYER; it += NGW) {
        const int l = it / I_LAYER; int r = it % I_LAYER; bf16_t* Wl = Wb + (size_t)l * W_LAYER;
        if (r < I_IN) { transpose_item(a.in[2] + (size_t)l * 1024 * 4864, 4864, Wl + W_IN, 1024, 0, scr, r, lane); continue; } r -= I_IN;
        if (r < I_A) { transpose_item(a.in[7] + (size_t)l * 256 * 1024, 1024, Wl + W_CAT, 1024, 0, scr, r, lane); continue; } r -= I_A;
        if (r < I_B) { transpose_item(a.in[8] + (size_t)l * 512 * 1024, 1024, Wl + W_CAT, 1024, 256, scr, r, lane); continue; } r -= I_B;
        if (r < I_C) { transpose_item(a.in[9] + (size_t)l * 256 * 1024, 1024, Wl + W_CAT, 1024, 768, scr, r, lane); continue; } r -= I_C;
        if (r < I_O) { transpose_item(a.in[10] + (size_t)l * 1024 * 1024, 1024, Wl + W_O, 1024, 0, scr, r, lane); continue; } r -= I_O;
        if (r < I_UP) { transpose_item(a.in[13] + (size_t)l * 1024 * 5632, 5632, Wl + W_UP, 1024, 0, scr, r, lane); continue; } r -= I_UP;
        if (r < I_DN) { transpose_item(a.in[15] + (size_t)l * 2816 * 1024, 1024, Wl + W_DOWN, 2816, 0, scr, r, lane); continue; } r -= I_DN;
        { const int g = r >> 1; transpose_item(a.in[3] + (size_t)l * 16384 + g * 4096, 64, Wl + W_POOL + g * 4096, 64, 0, scr, r & 1, lane); }
    }
    { const f32x4* x4 = (const f32x4*)a.in[0]; u32x4* o = (u32x4*)(a.ws + OFF_XB);
      const size_t n8 = (size_t)M * D / 8, gs = (size_t)gridDim.x * 512;
      for (size_t i = (size_t)blockIdx.x * 512 + tid; i < n8; i += gs) { const f32x4 p = x4[2 * i], q = x4[2 * i + 1];
          u32x4 w; w.x = pkbf(p[0], p[1]); w.y = pkbf(p[2], p[3]); w.z = pkbf(q[0], q[1]); w.w = pkbf(q[2], q[3]); o[i] = w; } }
    { float* tab = (float*)(a.ws + OFF_ROPE); const int* pos = (const int*)a.in[1];
      const size_t n = (size_t)M * 8, gs = (size_t)gridDim.x * 512;
      for (size_t i = (size_t)blockIdx.x * 512 + tid; i < n; i += gs) { const int m = (int)(i >> 3), f = (int)(i & 7);
          const double ang = (double)pos[m] * a.inv_freq[f]; const double rev = ang * 0.15915494309189533577; const float fr = (float)(rev - floor(rev));
          tab[(size_t)m * 16 + f] = __builtin_amdgcn_cosf(fr); tab[(size_t)m * 16 + 8 + f] = __builtin_amdgcn_sinf(fr); } }
}

__device__ __forceinline__ void mix_phase(const Args& a, unsigned char* ws, int l, unsigned char* lds_g) {
    int tid = threadIdx.x; asm volatile("" : "+v"(tid)); const int lane = tid & 63, wave = __builtin_amdgcn_readfirstlane(tid >> 6);
    const bf16_t* PA = (const bf16_t*)(ws + OFF_PA); bf16_t* OC = (bf16_t*)(ws + OFF_XB);
    const float* rope = (const float*)(ws + OFF_ROPE);
    const bf16_t* WPT = (const bf16_t*)(ws + OFF_W) + (size_t)l * W_LAYER + W_POOL;
    const float* pscale = a.in[4] + l * 256; const float* sinks = a.in[5] + l * 8; const float* convw = a.in[6] + l * 768;
    LAS unsigned char* lds = (LAS unsigned char*)lds_g;
    constexpr int KS_PITCH = 144, VT_PITCH = 528, VT_OFF = 256 * 144, US_PITCH = 528;
    const int fr = lane & 15, fq = lane >> 4;
    for (int item = blockIdx.x; item < 512; item += gridDim.x) {
        const int blk = item & 63; const int tok0 = item * 128;
        for (int kvh = 0; kvh < 2; ++kvh) {
            __syncthreads();
            { const int row = tid >> 1, half = tid & 1; const int token = tok0 - 128 + row; const bool valid = (blk > 0) || (row >= 128);
              u32x4 kc[4], vc[4];
#pragma unroll
              for (int c = 0; c < 4; ++c) { kc[c] = (u32x4){0u, 0u, 0u, 0u}; vc[c] = (u32x4){0u, 0u, 0u, 0u}; }
              if (valid) { const bf16_t* kp = PA + (size_t)token * NPA + 768 + kvh * 64 + half * 32; const bf16_t* vp = kp + 128;
#pragma unroll
                  for (int c = 0; c < 4; ++c) { kc[c] = *(const u32x4*)(kp + c * 8); vc[c] = *(const u32x4*)(vp + c * 8); }
                  if (half == 0) { const f32x4* rt = (const f32x4*)(rope + (size_t)token * 16); const f32x4 c0 = rt[0], c1 = rt[1], s0 = rt[2], s1 = rt[3];
                      const u32x4 x1 = kc[0], x2 = kc[1]; u32x4 y1, y2;
#pragma unroll
                      for (int e = 0; e < 4; ++e) { const float cl = e < 2 ? c0[2 * e] : c1[2 * e - 4], ch = e < 2 ? c0[2 * e + 1] : c1[2 * e - 3];
                          const float sl = e < 2 ? s0[2 * e] : s1[2 * e - 4], sh = e < 2 ? s0[2 * e + 1] : s1[2 * e - 3];
                          const float a1l = bflo(x1[e]), a1h = bfhi(x1[e]), a2l = bflo(x2[e]), a2h = bfhi(x2[e]);
                          y1[e] = pkbf(a1l * cl - a2l * sl, a1h * ch - a2h * sh); y2[e] = pkbf(a2l * cl + a1l * sl, a2h * ch + a1h * sh); }
                      kc[0] = y1; kc[1] = y2; } }
#pragma unroll
              for (int c = 0; c < 4; ++c) *(LAS u32x4*)(lds + row * KS_PITCH + (half * 32 + c * 8) * 2) = kc[c];
#pragma unroll
              for (int c = 0; c < 4; ++c)
#pragma unroll
                  for (int e = 0; e < 4; ++e) { const int d = half * 32 + c * 8 + 2 * e;
                      *(LAS unsigned short*)(lds + VT_OFF + d * VT_PITCH + row * 2) = (unsigned short)(vc[c][e] & 0xffffu);
                      *(LAS unsigned short*)(lds + VT_OFF + (d + 1) * VT_PITCH + row * 2) = (unsigned short)(vc[c][e] >> 16); }
            }
            __syncthreads();
            const int head = kvh * 4 + (wave >> 1); const float sink = sinks[head];
            for (int tile = 0; tile < 4; ++tile) {
                const int i0 = (wave & 1) * 64 + tile * 16; const int qtoken = tok0 + i0 + fr;
                const bf16_t* qp = PA + (size_t)qtoken * NPA + 256 + head * 64 + fq * 8;
                u32x4 q0 = *(const u32x4*)qp, q1 = *(const u32x4*)(qp + 32);
                { u32x4 other;
#pragma unroll
                  for (int e = 0; e < 4; ++e) other[e] = (unsigned)__shfl_xor((int)q0[e], 16);
                  const f32x4* rt = (const f32x4*)(rope + (size_t)qtoken * 16); const f32x4 c0 = rt[0], c1 = rt[1], s0 = rt[2], s1 = rt[3];
                  u32x4 y;
#pragma unroll
                  for (int e = 0; e < 4; ++e) { const float cl = e < 2 ? c0[2 * e] : c1[2 * e - 4], ch = e < 2 ? c0[2 * e + 1] : c1[2 * e - 3];
                      const float sl = e < 2 ? s0[2 * e] : s1[2 * e - 4], sh = e < 2 ? s0[2 * e + 1] : s1[2 * e - 3];
                      const float ml = bflo(q0[e]), mh = bfhi(q0[e]), ol = bflo(other[e]), oh = bfhi(other[e]);
                      float rl, rh;
                      if (fq == 0) { rl = ml * cl - ol * sl; rh = mh * ch - oh * sh; }
                      else if (fq == 1) { rl = ml * cl + ol * sl; rh = mh * ch + oh * sh; }
                      else { rl = ml; rh = mh; }
                      y[e] = pkbf(rl * 0.125f, rh * 0.125f); }
                  q0 = y;
#pragma unroll
                  for (int e = 0; e < 4; ++e) q1[e] = pkbf(bflo(q1[e]) * 0.125f, bfhi(q1[e]) * 0.125f); }
                const bf16x8 qf0 = __builtin_bit_cast(bf16x8, q0), qf1 = __builtin_bit_cast(bf16x8, q1);
                f32x4 s[9];
#pragma unroll
                for (int kb = 0; kb < 9; ++kb) { const int krow = i0 + kb * 16 + fr;
                    const bf16x8 k0 = *(const LAS bf16x8*)(lds + krow * KS_PITCH + fq * 16), k1 = *(const LAS bf16x8*)(lds + krow * KS_PITCH + 64 + fq * 16);
                    f32x4 c = (f32x4){0.f, 0.f, 0.f, 0.f};
                    c = __builtin_amdgcn_mfma_f32_16x16x32_bf16(k0, qf0, c, 0, 0, 0);
                    c = __builtin_amdgcn_mfma_f32_16x16x32_bf16(k1, qf1, c, 0, 0, 0);
                    s[kb] = c; }
                float mx = sink;
#pragma unroll
                for (int kb = 0; kb < 9; ++kb)
#pragma unroll
                    for (int j = 0; j < 4; ++j) { const int rel = kb * 16 + fq * 4 + j - fr; const int jk = i0 + kb * 16 + fq * 4 + j;
                        const bool ok = (rel > 0) && (rel <= 128) && ((blk > 0) || (jk >= 128));
                        const float v = ok ? s[kb][j] : -1e30f; s[kb][j] = v; mx = fmaxf(mx, v); }
                mx = fmaxf(mx, __shfl_xor(mx, 16)); mx = fmaxf(mx, __shfl_xor(mx, 32));
                float sum = 0.f;
#pragma unroll
                for (int kb = 0; kb < 9; ++kb)
#pragma unroll
                    for (int j = 0; j < 4; ++j) { const float p = __expf(s[kb][j] - mx); s[kb][j] = p; sum += p; }
                sum += __shfl_xor(sum, 16); sum += __shfl_xor(sum, 32);
                sum += __expf(sink - mx);
                const float inv = 1.0f / sum;
                f32x4 o[4];
#pragma unroll
                for (int nb = 0; nb < 4; ++nb) o[nb] = (f32x4){0.f, 0.f, 0.f, 0.f};
#pragma unroll
                for (int kk = 0; kk < 5; ++kk) {
                    u32x4 pw; pw.x = pkbf(s[2 * kk][0], s[2 * kk][1]); pw.y = pkbf(s[2 * kk][2], s[2 * kk][3]);
                    if (kk < 4) { pw.z = pkbf(s[2 * kk + 1][0], s[2 * kk + 1][1]); pw.w = pkbf(s[2 * kk + 1][2], s[2 * kk + 1][3]); } else { pw.z = 0u; pw.w = 0u; }
                    const bf16x8 pf = __builtin_bit_cast(bf16x8, pw);
#pragma unroll
                    for (int nb = 0; nb < 4; ++nb) { const int d = nb * 16 + fr;
                        const LAS unsigned char* vb = lds + VT_OFF + d * VT_PITCH + (i0 + 32 * kk + 4 * fq) * 2;
                        u32x2 lo = *(const LAS u32x2*)vb; u32x2 hi = (u32x2){0u, 0u};
                        if (kk < 4) hi = *(const LAS u32x2*)(vb + 32);
                        u32x4 vw; vw.x = lo.x; vw.y = lo.y; vw.z = hi.x; vw.w = hi.y;
                        o[nb] = __builtin_amdgcn_mfma_f32_16x16x32_bf16(__builtin_bit_cast(bf16x8, vw), pf, o[nb], 0, 0, 0); } }
                bf16_t* op = OC + (size_t)qtoken * D + 256 + head * 64 + fq * 4;
#pragma unroll
                for (int nb = 0; nb < 4; ++nb) { u32x2 w; w.x = pkbf(o[nb][0] * inv, o[nb][1] * inv); w.y = pkbf(o[nb][2] * inv, o[nb][3] * inv); *(u32x2*)(op + nb * 16) = w; }
            }
        }
        __syncthreads();
        for (int ch = tid; ch < 143 * 32; ch += 512) { const int r = ch >> 5, c = ch & 31; const bool valid = (blk > 0) || (r >= 15);
            u32x4 v = (u32x4){0u, 0u, 0u, 0u};
            if (valid) v = *(const u32x4*)(PA + (size_t)(tok0 - 15 + r) * NPA + c * 8);
            *(LAS u32x4*)(lds + r * US_PITCH + c * 16) = v; }
        __syncthreads();
        {
            const int i = wave * 16 + fr; const int sidx = blk * 128 + i; const int token = tok0 + i;
#pragma unroll
            for (int g = 0; g < 4; ++g) { const int w = 2 << g; const float rc = 1.0f / (float)min(sidx + 1, w);
                bf16x8 pf[2];
#pragma unroll
                for (int ks = 0; ks < 2; ++ks) { const int cb = (g * 64 + ks * 32 + fq * 8) * 2;
                    float acc8[8];
#pragma unroll
                    for (int e = 0; e < 8; ++e) acc8[e] = 0.f;
                    for (int jj = 0; jj < w; ++jj) { const u32x4 v = *(const LAS u32x4*)(lds + (15 + i - jj) * US_PITCH + cb);
#pragma unroll
                        for (int e = 0; e < 4; ++e) { acc8[2 * e] += bflo(v[e]); acc8[2 * e + 1] += bfhi(v[e]); } }
                    const u32x4 self = *(const LAS u32x4*)(lds + (15 + i) * US_PITCH + cb);
                    u32x4 pw;
#pragma unroll
                    for (int e = 0; e < 4; ++e) pw[e] = pkbf(acc8[2 * e] * rc - bflo(self[e]), acc8[2 * e + 1] * rc - bfhi(self[e]));
                    pf[ks] = __builtin_bit_cast(bf16x8, pw); }
#pragma unroll
                for (int nb = 0; nb < 4; ++nb) { f32x4 c = (f32x4){0.f, 0.f, 0.f, 0.f};
#pragma unroll
                    for (int ks = 0; ks < 2; ++ks) { const bf16x8 wf = *(const bf16x8*)(WPT + g * 4096 + (nb * 16 + fr) * 64 + ks * 32 + fq * 8);
                        c = __builtin_amdgcn_mfma_f32_16x16x32_bf16(wf, pf[ks], c, 0, 0, 0); }
                    const int dcol = g * 64 + nb * 16 + fq * 4; const f32x4 sc = *(const f32x4*)(pscale + dcol);
                    u32x2 wv; wv.x = pkbf(c[0] * sc[0], c[1] * sc[1]); wv.y = pkbf(c[2] * sc[2], c[3] * sc[3]);
                    *(u32x2*)(OC + (size_t)token * D + dcol) = wv; } }
        }
        for (int ch = tid; ch < 128 * 32; ch += 512) { const int i = ch >> 5, c = (ch & 31) * 8; const int sidx = blk * 128 + i; const size_t token = (size_t)tok0 + i;
            float y[8];
#pragma unroll
            for (int e = 0; e < 8; ++e) y[e] = 0.f;
#pragma unroll
            for (int k = 0; k < 3; ++k) { const int back = 2 - k;
                if (sidx - back >= 0) { const bf16_t* p = PA + (token - back) * NPA; const u32x4 xv = *(const u32x4*)(p + 1024 + c), gv = *(const u32x4*)(p + 1536 + c);
                    const f32x4 w0 = *(const f32x4*)(convw + k * 256 + c), w1 = *(const f32x4*)(convw + k * 256 + c + 4);
#pragma unroll
                    for (int e = 0; e < 4; ++e) { const float wl = e < 2 ? w0[2 * e] : w1[2 * e - 4], wh = e < 2 ? w0[2 * e + 1] : w1[2 * e - 3];
                        y[2 * e] += wl * bflo(xv[e]) * bflo(gv[e]); y[2 * e + 1] += wh * bfhi(xv[e]) * bfhi(gv[e]); } } }
            const u32x4 gb = *(const u32x4*)(PA + token * NPA + 1280 + c);
            u32x4 o;
#pragma unroll
            for (int e = 0; e < 4; ++e) o[e] = pkbf(y[2 * e] * bflo(gb[e]), y[2 * e + 1] * bfhi(gb[e]));
            *(u32x4*)(OC + token * D + 768 + c) = o; }
    }
}

__device__ __forceinline__ void ln_phase(const float* pre, float* xout, bf16_t* xb, const float* g, const float* b) {
    int tid = threadIdx.x; asm volatile("" : "+v"(tid)); const int lane = tid & 63, wave = __builtin_amdgcn_readfirstlane(tid >> 6);
    const int gw = blockIdx.x * 8 + wave, NGW = gridDim.x * 8;
    f32x4 gv[4], bv[4];
#pragma unroll
    for (int j = 0; j < 4; ++j) { gv[j] = ((const f32x4*)g)[lane + 64 * j]; bv[j] = ((const f32x4*)b)[lane + 64 * j]; }
    for (int m = gw; m < M; m += NGW) {
        const f32x4* xr = (const f32x4*)(pre + (size_t)m * D) + lane;
        f32x4 v[4]; float s = 0.f;
#pragma unroll
        for (int j = 0; j < 4; ++j) { v[j] = xr[64 * j]; s += (v[j][0] + v[j][1]) + (v[j][2] + v[j][3]); }
        const float mean = wave_sum(s) * (1.f / D); float s2 = 0.f;
#pragma unroll
        for (int j = 0; j < 4; ++j) { v[j] = v[j] - mean; s2 += (v[j][0] * v[j][0] + v[j][1] * v[j][1]) + (v[j][2] * v[j][2] + v[j][3] * v[j][3]); }
        const float rstd = 1.f / sqrtf(wave_sum(s2) * (1.f / D) + LN_EPS);
        f32x4* o4 = (f32x4*)(xout + (size_t)m * D) + lane; u32x2* o2 = (u32x2*)(xb + (size_t)m * D) + lane;
#pragma unroll
        for (int j = 0; j < 4; ++j) { const f32x4 y = v[j] * rstd * gv[j] + bv[j]; o4[64 * j] = y; u32x2 w; w.x = pkbf(y[0], y[1]); w.y = pkbf(y[2], y[3]); o2[64 * j] = w; }
    }
}

__device__ __forceinline__ void act_phase(const Args& a, unsigned char* ws, int l, int hf) {
    const bf16_t* UP = (const bf16_t*)(ws + OFF_UP); bf16_t* H = (bf16_t*)(ws + OFF_H) + (size_t)hf * MH * FF;
    const float* cw = a.in[14] + (size_t)l * 3 * NUP;
    const int NCG = FF / 8, NCH = MH / 16;
    int tid = threadIdx.x; asm volatile("" : "+v"(tid));
    const size_t total = (size_t)NCG * NCH, gs = (size_t)gridDim.x * 512;
    for (size_t it = (size_t)blockIdx.x * 512 + tid; it < total; it += gs) {
        const int cg8 = (int)(it % NCG) * 8, t0 = (int)(it / NCG) * 16;
        float wa[3][8], wb[3][8];
#pragma unroll
        for (int k = 0; k < 3; ++k) { const f32x4 p0 = *(const f32x4*)(cw + k * NUP + cg8), p1 = *(const f32x4*)(cw + k * NUP + cg8 + 4);
            const f32x4 q0 = *(const f32x4*)(cw + k * NUP + FF + cg8), q1 = *(const f32x4*)(cw + k * NUP + FF + cg8 + 4);
#pragma unroll
            for (int e = 0; e < 4; ++e) { wa[k][e] = p0[e]; wa[k][4 + e] = p1[e]; wb[k][e] = q0[e]; wb[k][4 + e] = q1[e]; } }
        u32x4 a2 = (u32x4){0u, 0u, 0u, 0u}, a1 = a2, b2 = a2, b1 = a2;
        if ((t0 & (SEQ - 1)) != 0) { const bf16_t* p = UP + (size_t)(t0 - 2) * NUP + cg8; a2 = *(const u32x4*)p; b2 = *(const u32x4*)(p + FF); a1 = *(const u32x4*)(p + NUP); b1 = *(const u32x4*)(p + NUP + FF); }
        for (int tt = 0; tt < 16; ++tt) { const bf16_t* p = UP + (size_t)(t0 + tt) * NUP + cg8; const u32x4 a0 = *(const u32x4*)p, b0 = *(const u32x4*)(p + FF);
            u32x4 o;
#pragma unroll
            for (int e = 0; e < 4; ++e) {
                const float al = wa[0][2 * e] * bflo(a2[e]) + wa[1][2 * e] * bflo(a1[e]) + wa[2][2 * e] * bflo(a0[e]);
                const float ah = wa[0][2 * e + 1] * bfhi(a2[e]) + wa[1][2 * e + 1] * bfhi(a1[e]) + wa[2][2 * e + 1] * bfhi(a0[e]);
                const float bl = wb[0][2 * e] * bflo(b2[e]) + wb[1][2 * e] * bflo(b1[e]) + wb[2][2 * e] * bflo(b0[e]);
                const float bh = wb[0][2 * e + 1] * bfhi(b2[e]) + wb[1][2 * e + 1] * bfhi(b1[e]) + wb[2][2 * e + 1] * bfhi(b0[e]);
                o[e] = pkbf(al * fast_sigmoid(al) * bl, ah * fast_sigmoid(ah) * bh); }
            *(u32x4*)(H + (size_t)(t0 + tt) * FF + cg8) = o;
            a2 = a1; a1 = a0; b2 = b1; b1 = b0; }
    }
}

#define XB_TMO      128
#define XB_XCNT(j)  (256  + 64 * (j))
#define XB_XSUB(j)  (1280 + 64 * (j))
#define XB_XGEN(j)  (2304 + 64 * (j))
#define XB_TOP      3328
#define XB_TOPGEN   3392
#define XCD_BAR_WORDS 3456
#define XB_SPIN_CAP (1u << 18)

__device__ __forceinline__ unsigned xb_ld(unsigned* p)              { return __hip_atomic_load(p, __ATOMIC_RELAXED, __HIP_MEMORY_SCOPE_AGENT); }
__device__ __forceinline__ unsigned xb_add(unsigned* p, unsigned v) { return __hip_atomic_fetch_add(p, v, __ATOMIC_RELAXED, __HIP_MEMORY_SCOPE_AGENT); }
__device__ __forceinline__ unsigned xb_xcc_id() { return (unsigned)__builtin_amdgcn_s_getreg((3 << 11) | 20) & 0xFu; }
#define XB_SPIN(cond, bar) do { unsigned _sp = 0; while (cond) { __builtin_amdgcn_s_sleep(1); \
    if ((++_sp & 255u) == 0u) { if (xb_ld(&(bar)[XB_TMO])) break; if (_sp > XB_SPIN_CAP) { atomicAdd(&(bar)[XB_TMO], 1u); break; } } } } while (0)

struct XcdBarrier {
    unsigned* bar; unsigned x;
    volatile LAS unsigned* st;
};

__device__ __forceinline__ XcdBarrier xcd_barrier_post(unsigned* bar, volatile LAS unsigned* st) {
    XcdBarrier b; b.bar = bar; b.x = xb_xcc_id(); b.st = st;
    if (threadIdx.x == 0) (void)xb_add(&bar[XB_XCNT(b.x)], 1u);
    return b;
}
__device__ __forceinline__ void xcd_barrier_complete(unsigned* bar, unsigned x, unsigned& nloc, unsigned& nx) {
    const unsigned G = gridDim.x * gridDim.y * gridDim.z;
    unsigned sum, cnt, mine, sp = 0u;
    for (;;) {
        sum = 0u; cnt = 0u; mine = 0u;
#pragma unroll
        for (unsigned j = 0; j < 16; ++j) { const unsigned c = xb_ld(&bar[XB_XCNT(j)]); sum += c; cnt += (c > 0u) ? 1u : 0u; mine = (j == x) ? c : mine; }
        if (sum == G) break;
        __builtin_amdgcn_s_sleep(1);
        if ((++sp & 255u) == 0u) { if (xb_ld(&bar[XB_TMO])) break; if (sp > XB_SPIN_CAP) { atomicAdd(&bar[XB_TMO], 1u); break; } }
    }
    nloc = mine > 0u ? mine : 1u; nx = cnt > 0u ? cnt : 1u;
}

__device__ __forceinline__ void xcd_barrier(const XcdBarrier& b) {
    asm volatile("s_waitcnt vmcnt(0)" ::: "memory");
    __syncthreads();
    if (threadIdx.x == 0) {
        unsigned* bar = b.bar;
        __builtin_amdgcn_s_waitcnt(0);
        unsigned nloc = b.st[0], nx = b.st[1];
        if (nloc == 0u) { xcd_barrier_complete(bar, b.x, nloc, nx); b.st[0] = nloc; b.st[1] = nx; }
        const unsigned old = xb_add(&bar[XB_XSUB(b.x)], 1u);
        const unsigned gen = old / nloc;
        if (old + 1u == (gen + 1u) * nloc) {
            __builtin_amdgcn_fence(__ATOMIC_RELEASE, "agent");
            asm volatile("s_waitcnt vmcnt(0)" ::: "memory");
            const unsigned og = xb_add(&bar[XB_TOP], 1u);
            const unsigned tg = og / nx;
            if (og + 1u == (tg + 1u) * nx) xb_add(&bar[XB_TOPGEN], 1u);
            else XB_SPIN(xb_ld(&bar[XB_TOPGEN]) == tg, bar);
            __builtin_amdgcn_fence(__ATOMIC_ACQUIRE, "agent");
            xb_add(&bar[XB_XGEN(b.x)], 1u);
            asm volatile("s_waitcnt vmcnt(0)" ::: "memory");
        } else {
            XB_SPIN(xb_ld(&bar[XB_XGEN(b.x)]) == gen, bar);
            __builtin_amdgcn_fence(__ATOMIC_ACQUIRE, "agent");
            asm volatile("s_waitcnt vmcnt(0)" ::: "memory");
        }
    }
    __syncthreads();
}

__global__ void __launch_bounds__(512, 2) fwd_mega(Args a) {
    extern __shared__ __attribute__((aligned(16))) unsigned char lds[];
    cg::grid_group grid = cg::this_grid();
    const int G = gridDim.x;
#define LAUNDER(x) do { int _t = __builtin_amdgcn_readfirstlane((int)(x)); asm volatile("" : "+s"(_t)); (x) = _t; } while (0)
#define LAUNDERP(T, p) do { unsigned long long _u = (unsigned long long)(p); unsigned _lo = __builtin_amdgcn_readfirstlane((unsigned)_u), _hi = __builtin_amdgcn_readfirstlane((unsigned)(_u >> 32)); \
    asm volatile("" : "+s"(_lo), "+s"(_hi)); (p) = (T)(((unsigned long long)_hi << 32) | _lo); } while (0)
#define PH_ENTER unsigned char* ws = a.ws; float* out = a.out; int l = lq; LAUNDERP(unsigned char*, ws); LAUNDERP(float*, out); LAUNDER(l); bf16_t* Wl = (bf16_t*)(ws + OFF_W) + (size_t)l * W_LAYER; (void)Wl; (void)out;
    { unsigned* bw = (unsigned*)(a.ws + OFF_CTL); if (blockIdx.x == 0) for (int i = threadIdx.x; i < XCD_BAR_WORDS; i += 512) bw[i] = 0u;
      if (threadIdx.x < 4) ((LAS unsigned*)((LAS unsigned char*)lds + 131072))[threadIdx.x] = 0u; }
    REP(1) if (PHM & 1) { prologue_phase(a, lds); }
    __syncthreads(); grid.sync();
    (void)xcd_barrier_post((unsigned*)(a.ws + OFF_CTL), (volatile LAS unsigned*)((LAS unsigned char*)lds + 131072));
#define GSYNC do { XcdBarrier xb_; unsigned char* w_ = a.ws; LAUNDERP(unsigned char*, w_); xb_.bar = (unsigned*)(w_ + OFF_CTL); xb_.x = xb_xcc_id(); \
        xb_.st = (volatile LAS unsigned*)((LAS unsigned char*)lds + 131072); xcd_barrier(xb_); } while (0)
#pragma clang loop unroll(disable)
    for (int lq = 0; lq < DEPTH; ++lq) {
        REP(2) if (PHM & 2) { PH_ENTER pg8::Gemm g{(bf16_t*)(ws + OFF_XB), Wl + W_IN, M, NIN, D}; pg8::StaticOrder S; S.init(M, NIN, G, (int)blockIdx.x); EpiProj E{(bf16_t*)(ws + OFF_PA), (bf16_t*)(ws + OFF_GT)};
            pg8::gemm_phase<EpiProj, pg8::StaticOrder>((PG8_LAS unsigned char*)lds, g, S, E); } GSYNC;
        REP(4) if (PHM & 4) { PH_ENTER mix_phase(a, ws, l, lds); } GSYNC;
        REP(8) if (PHM & 8) { PH_ENTER pg8::Gemm g{(bf16_t*)(ws + OFF_XB), Wl + W_CAT, M, D, D}; pg8::StaticOrder S; S.init(M, D, G, (int)blockIdx.x); EpiMerge E{(bf16_t*)(ws + OFF_GT), (bf16_t*)(ws + OFF_MG)};
            pg8::gemm_phase<EpiMerge, pg8::StaticOrder>((PG8_LAS unsigned char*)lds, g, S, E); } GSYNC;
        if (PHM & 16) { PH_ENTER pg8::Gemm g{(bf16_t*)(ws + OFF_MG), Wl + W_O, M, D, D}; pg8::StaticOrder S; S.init(M, D, G, (int)blockIdx.x); EpiRes E{l == 0 ? a.in[0] : (const float*)out, out};
            pg8::gemm_phase<EpiRes, pg8::StaticOrder>((PG8_LAS unsigned char*)lds, g, S, E); } GSYNC;
        if (PHM & 32) { PH_ENTER ln_phase(out, out, (bf16_t*)(ws + OFF_XB), a.in[11] + l * D, a.in[12] + l * D); } GSYNC;
#pragma clang loop unroll(disable)
        for (int hq = 0; hq < 2; ++hq) {
            REP(64) if (PHM & 64) { PH_ENTER int hf = hq; LAUNDER(hf); pg8::Gemm g{(bf16_t*)(ws + OFF_XB) + (size_t)hf * MH * D, Wl + W_UP, MH, NUP, D}; pg8::StaticOrder S; S.init(MH, NUP, G, (int)blockIdx.x); EpiBf E{(bf16_t*)(ws + OFF_UP), NUP};
                pg8::gemm_phase<EpiBf, pg8::StaticOrder>((PG8_LAS unsigned char*)lds, g, S, E); } GSYNC;
            REP(128) if (PHM & 128) { PH_ENTER int hf = hq; LAUNDER(hf); act_phase(a, ws, l, hf); } GSYNC;
        }
        if (PHM & 256) { PH_ENTER pg8::Gemm g{(bf16_t*)(ws + OFF_H), Wl + W_DOWN, M, D, FF}; pg8::StaticOrder S; S.init(M, D, G, (int)blockIdx.x); EpiRes E{(const float*)out, out};
            pg8::gemm_phase<EpiRes, pg8::StaticOrder>((PG8_LAS unsigned char*)lds, g, S, E); } GSYNC;
        if (PHM & 512) { PH_ENTER ln_phase(out, out, (bf16_t*)(ws + OFF_XB), a.in[16] + l * D, a.in[17] + l * D); } if (lq + 1 < DEPTH) GSYNC;
    }
}
constexpr int N_PHASES = 1 + DEPTH * 11;

extern "C" void kernel_launch(void* const* d_in, const int* in_sizes, int n_in, void* d_out, int out_size, void* d_ws, size_t ws_size, hipStream_t stream) {
    static int grid = 0;
    if (grid == 0) {
        int dev = 0, cus = 0, per_cu = 0;
        (void)hipGetDevice(&dev); (void)hipDeviceGetAttribute(&cus, hipDeviceAttributeMultiprocessorCount, dev);
        if (hipFuncSetAttribute((const void*)fwd_mega, hipFuncAttributeMaxDynamicSharedMemorySize, LDS_BYTES) != hipSuccess) fprintf(stderr, "kernel_launch: hipFuncSetAttribute failed\n");
        if (hipOccupancyMaxActiveBlocksPerMultiprocessor(&per_cu, (const void*)fwd_mega, 512, LDS_BYTES) != hipSuccess || per_cu < 1) { fprintf(stderr, "kernel_launch: occupancy query says %d\n", per_cu); per_cu = 1; }
        (void)hipGetLastError();
        grid = cus * per_cu;
        if (n_in != 18 || out_size != M * D || ws_size < WS_NEED) fprintf(stderr, "kernel_launch: unexpected shapes n_in %d out %d ws %zu (need %zu)\n", n_in, out_size, ws_size, (size_t)WS_NEED);
        fprintf(stderr, "kernel_launch: grid %d (cus %d x %d), ws %zu\n", grid, cus, per_cu, ws_size);
    }
    Args a{};
    for (int i = 0; i < 18; ++i) a.in[i] = (const float*)d_in[i];
    a.out = (float*)d_out; a.ws = (unsigned char*)d_ws;
    for (int i = 0; i < 8; ++i) a.inv_freq[i] = std::pow(500000.0, -(double)(2 * i) / 16.0);
    void* args[] = {&a};
    hipError_t e = hipLaunchCooperativeKernel((void*)fwd_mega, dim3(grid), dim3(512), args, LDS_BYTES, stream);
    if (e != hipSuccess) fprintf(stderr, "kernel_launch: cooperative launch failed: %s (grid %d)\n", hipGetErrorString(e), grid);
}
```
